# Optimizing an MI355X kernel written in HIP

```python
import jax, jax.numpy as jnp
from jax import lax
import numpy as np

D_MODEL = 1024
BATCH = 2
SEQ = 16384
DEPTH = 1
DEC_BATCH = 8
DEC_SEQ = 16
PAST_LEN = 2048

CHUNK = 64
D_MIX = D_MODEL
A_WIDTH = D_MIX // 2
A_GROUPS = 8
A_GDIM = A_WIDTH // A_GROUPS
MLP_CHUNK = 128
B_WIDTH = D_MIX - A_WIDTH
B_HEADS = 8
B_HDIM = B_WIDTH // B_HEADS
LEFT_CHUNKS = 8
KV_WIN = LEFT_CHUNKS * CHUNK
BAND = KV_WIN + CHUNK
REL_CLIP = 128
N_REL = 2 * REL_CLIP + 1
EPS = 1e-6
D_IN = 3 * A_WIDTH + 4 * B_WIDTH
SPLITS = [A_WIDTH, 2 * A_WIDTH, 3 * A_WIDTH, 3 * A_WIDTH + B_WIDTH,
          3 * A_WIDTH + 2 * B_WIDTH, 3 * A_WIDTH + 3 * B_WIDTH]
NEG = -1e30

kernel_name = "hymba_gmlp_chunkband_stream_step"


def rmsnorm(x, g):
    xf = x.astype(jnp.float32)
    y = xf * lax.rsqrt(jnp.mean(xf * xf, -1, keepdims=True) + EPS)
    return (y * g.astype(jnp.float32)).astype(x.dtype)


def layernorm(x, g, b):
    xf = x.astype(jnp.float32)
    mu = jnp.mean(xf, -1, keepdims=True)
    xc = xf - mu
    var = jnp.mean(xc * xc, -1, keepdims=True)
    y = xc * lax.rsqrt(var + EPS) * g.astype(jnp.float32) + b.astype(jnp.float32)
    return y.astype(x.dtype)


def rel_bias_lookup(rel_bias, dist):
    idx = jnp.clip(dist, -REL_CLIP, REL_CLIP) + REL_CLIP
    return jnp.take(rel_bias, idx, axis=1).astype(jnp.float32)


def mixer_inputs(x, c, g_pre, w_ada, b_ada, w_in, ln_g, ln_b):
    mod = jax.nn.silu(c) @ w_ada + b_ada
    shift, scale, gate = jnp.split(mod[:, None, :], 3, axis=-1)
    h = rmsnorm(x, g_pre) * (1 + scale) + shift
    z = h @ w_in
    uA, vA, gA, q, k, v, gB = jnp.split(z, SPLITS, axis=-1)
    uA = jax.nn.gelu(uA)
    vA = layernorm(jax.nn.gelu(vA), ln_g, ln_b)
    bsz, t = x.shape[0], x.shape[1]
    q = q.reshape(bsz, t, B_HEADS, B_HDIM)
    k = k.reshape(bsz, t, B_HEADS, B_HDIM)
    v = v.reshape(bsz, t, B_HEADS, B_HDIM)
    return gate, uA, vA, gA, q, k, v, gB


def mixer_output(x, gate, yA, gA, yB, gB, w_out, g_post):
    bsz, t = x.shape[0], x.shape[1]
    o = jnp.concatenate([yA * jax.nn.silu(gA),
                         yB.reshape(bsz, t, B_WIDTH) * jax.nn.silu(gB)], axis=-1) @ w_out
    return x + gate * rmsnorm(o, g_post)


def gmlp_prompt(u, v, w_s, b_s):
    bsz, s, _ = u.shape
    n = s // MLP_CHUNK
    vg = v.reshape(bsz, n, MLP_CHUNK, A_GROUPS, A_GDIM)
    mask = jnp.tril(jnp.ones((MLP_CHUNK, MLP_CHUNK), dtype=bool))
    ws = jnp.where(mask[None], w_s, jnp.zeros_like(w_s))
    mixed = jnp.einsum('gts,bnsgd->bntgd', ws, vg) + b_s.T[None, None, :, :, None]
    return u * mixed.reshape(bsz, s, A_WIDTH)


def gmlp_sample(u, v, w_s, b_s):
    bsz, t, _ = u.shape
    vg = v.reshape(bsz, t, A_GROUPS, A_GDIM)
    mask = jnp.tril(jnp.ones((t, t), dtype=bool))
    ws = w_s[:, :t, :t]
    ws = jnp.where(mask[None], ws, jnp.zeros_like(ws))
    mixed = jnp.einsum('gts,bsgd->btgd', ws, vg) + b_s[:, :t].T[None, :, :, None]
    return u * mixed.reshape(bsz, t, A_WIDTH)


def band_attention_prompt(q, k, v, rel_bias):
    bsz, s, nh, dh = q.shape
    n_chunks = s // CHUNK
    pad = ((0, 0), (KV_WIN, 0), (0, 0), (0, 0))
    kp = jnp.pad(k, pad)
    vp = jnp.pad(v, pad)
    kpos = jnp.arange(BAND)
    qpos = jnp.arange(CHUNK) + KV_WIN
    bias = rel_bias_lookup(rel_bias, qpos[:, None] - kpos[None, :])
    scale = dh ** -0.5

    def one_chunk(ci):
        start = ci * CHUNK
        qc = lax.dynamic_slice_in_dim(q, start, CHUNK, axis=1)
        kc = lax.dynamic_slice_in_dim(kp, start, BAND, axis=1)
        vc = lax.dynamic_slice_in_dim(vp, start, BAND, axis=1)
        valid = (kpos + start - KV_WIN) >= 0
        sc = jnp.einsum('bqhd,bkhd->bhqk', qc, kc,
                        preferred_element_type=jnp.float32) * scale + bias[None]
        sc = jnp.where(valid[None, None, None, :], sc, NEG)
        p = jax.nn.softmax(sc, axis=-1).astype(vc.dtype)
        return jnp.einsum('bhqk,bkhd->bqhd', p, vc)

    out = lax.map(one_chunk, jnp.arange(n_chunks))
    return out.transpose(1, 0, 2, 3, 4).reshape(bsz, s, nh, dh)


def band_attention_sample(q, k_new, v_new, k_cache, v_cache, rel_bias):
    w = k_cache.shape[1]
    t = q.shape[1]
    k = jnp.concatenate([k_cache.astype(k_new.dtype), k_new], axis=1)
    v = jnp.concatenate([v_cache.astype(v_new.dtype), v_new], axis=1)
    kpos = jnp.arange(w + t)
    qpos = w + jnp.arange(t)
    bias = rel_bias_lookup(rel_bias, qpos[:, None] - kpos[None, :])
    scale = q.shape[-1] ** -0.5
    sc = jnp.einsum('bqhd,bkhd->bhqk', q, k,
                    preferred_element_type=jnp.float32) * scale + bias[None]
    p = jax.nn.softmax(sc, axis=-1).astype(v.dtype)
    return jnp.einsum('bhqk,bkhd->bqhd', p, v)


def setup_inputs(seed: int = 0) -> dict:
    key = jax.random.key(seed)
    ks = jax.random.split(key, 20)
    f32 = jnp.float32
    win_rows = min(KV_WIN, PAST_LEN)
    nrm = lambda k_, shape: jax.random.normal(k_, shape, f32)
    return {
        "x_prompt": nrm(ks[0], (BATCH, SEQ, D_MODEL)),
        "x_sample": nrm(ks[1], (DEC_BATCH, DEC_SEQ, D_MODEL)),
        "cache_attn_k": nrm(ks[2], (DEPTH, DEC_BATCH, win_rows, B_HEADS, B_HDIM)),
        "cache_attn_v": nrm(ks[3], (DEPTH, DEC_BATCH, win_rows, B_HEADS, B_HDIM)),
        "c_prompt": nrm(ks[4], (BATCH, D_MODEL)),
        "c_sample": nrm(ks[5], (DEC_BATCH, D_MODEL)),
        "g_pre": 1.0 + 0.02 * nrm(ks[6], (DEPTH, D_MODEL)),
        "w_ada": 0.5 * D_MODEL ** -0.5 * nrm(ks[7], (DEPTH, D_MODEL, 3 * D_MODEL)),
        "b_ada": 0.02 * nrm(ks[8], (DEPTH, 3 * D_MODEL)),
        "w_in": D_MODEL ** -0.5 * nrm(ks[9], (DEPTH, D_MODEL, D_IN)),
        "ln_g": 1.0 + 0.02 * nrm(ks[10], (DEPTH, A_WIDTH)),
        "ln_b": 0.02 * nrm(ks[11], (DEPTH, A_WIDTH)),
        "w_s": MLP_CHUNK ** -0.5 * nrm(ks[12], (DEPTH, A_GROUPS, MLP_CHUNK, MLP_CHUNK)),
        "b_s": 1.0 + 0.02 * nrm(ks[13], (DEPTH, A_GROUPS, MLP_CHUNK)),
        "rel_bias": 0.1 * nrm(ks[14], (DEPTH, B_HEADS, N_REL)),
        "w_out": D_MIX ** -0.5 * nrm(ks[15], (DEPTH, D_MIX, D_MODEL)),
        "g_post": 1.0 + 0.02 * nrm(ks[16], (DEPTH, D_MODEL)),
    }


def reference(x_prompt, x_sample, cache_attn_k, cache_attn_v, c_prompt, c_sample,
              g_pre, w_ada, b_ada, w_in, ln_g, ln_b, w_s, b_s, rel_bias, w_out, g_post):
    yp = x_prompt
    ys = x_sample
    kp_rows, vp_rows, ks_rows, vs_rows, va_rows = [], [], [], [], []
    prompt_rows = min(KV_WIN, x_prompt.shape[1])
    for l in range(DEPTH):
        gate, uA, vA, gA, q, k, v, gB = mixer_inputs(yp, c_prompt, g_pre[l], w_ada[l], b_ada[l],
                                                     w_in[l], ln_g[l], ln_b[l])
        yA = gmlp_prompt(uA, vA, w_s[l], b_s[l])
        yB = band_attention_prompt(q, k, v, rel_bias[l])
        kp_rows.append(k[:, -prompt_rows:])
        vp_rows.append(v[:, -prompt_rows:])
        yp = mixer_output(yp, gate, yA, gA, yB, gB, w_out[l], g_post[l])

        gate, uA, vA, gA, q, k, v, gB = mixer_inputs(ys, c_sample, g_pre[l], w_ada[l], b_ada[l],
                                                     w_in[l], ln_g[l], ln_b[l])
        yA = gmlp_sample(uA, vA, w_s[l], b_s[l])
        yB = band_attention_sample(q, k, v, cache_attn_k[l], cache_attn_v[l], rel_bias[l])
        ks_rows.append(k)
        vs_rows.append(v)
        va_rows.append(vA)
        ys = mixer_output(ys, gate, yA, gA, yB, gB, w_out[l], g_post[l])

    new_k_prompt = jnp.stack(kp_rows)
    new_v_prompt = jnp.stack(vp_rows)
    new_k_sample = jnp.stack(ks_rows)
    new_v_sample = jnp.stack(vs_rows)
    new_gmlp_v_sample = jnp.stack(va_rows)
    return (yp, ys, new_k_prompt, new_v_prompt, new_k_sample, new_v_sample, new_gmlp_v_sample)
```

```cpp
#include <hip/hip_runtime.h>
#include <hip/hip_cooperative_groups.h>
#include <cstdio>
#include <cstdint>
namespace cg = cooperative_groups;
namespace pg8 {
#define PG8_LAS __attribute__((address_space(3)))
typedef unsigned short bf16_t;
typedef short bf16x8 __attribute__((ext_vector_type(8)));
typedef float f32x4 __attribute__((ext_vector_type(4)));
typedef unsigned u32x4 __attribute__((ext_vector_type(4)));
constexpr int BM = 256, BK = 64, HALF = 128, HTB = HALF * BK * 2  , STAGE_BYTES = 8 * HTB, NXCD = 8, WGM = 8;

__host__ __device__ __forceinline__ int lds_byte(int r, int c) { const int st = (r >> 4) * 2 + (c >> 5), rr = r & 15, cc = c & 31, ob = rr * 64 + cc * 2; return st * 1024 + (ob ^ (((ob >> 9) & 1) << 5)); }
__host__ __device__ __forceinline__ void stage_rc(int b, int& R, int& C) { const int st = b / 1024, sb = b % 1024, swz = sb ^ (((sb >> 9) & 1) << 5); R = (st >> 1) * 16 + swz / 64; C = (st & 1) * 32 + (swz % 64) / 2; }
__host__ __device__ __forceinline__ int perm32(int rho) { const int n = rho >> 4, i = rho & 15; return 8 * (i >> 2) + 4 * n + (i & 3); }

struct Unit { int pm, pn; };
struct Gemm { const bf16_t* A; const bf16_t* Bt; int M, N, K; };

struct StaticOrder {
    int nM, nN, nwg, G, c;
    __host__ __device__ void init(int M, int N, int G_, int c_) { nM = M / BM; nN = N / BM; nwg = nM * nN; G = G_; c = c_; }
    __host__ __device__ bool next(int i, Unit& u) const {
        const long L = (long)i * G + c; if (L >= nwg) return false;
        int wgid = (int)L; { const int q = nwg / NXCD, r = nwg % NXCD, xcd = wgid % NXCD, off = wgid / NXCD; wgid = (xcd < r ? xcd * (q + 1) : r * (q + 1) + (xcd - r) * q) + off; }
        const int nig = WGM * nN, gid = wgid / nig, fm = gid * WGM, gsz = (nM - fm) < WGM ? (nM - fm) : WGM;
        u.pm = fm + ((wgid % nig) % gsz); u.pn = (wgid % nig) / gsz; return true;
    }
    __device__ __forceinline__ void a_ready(const Unit&) const {}
    __device__ __forceinline__ void done(const Unit&) const {}
};

__device__ __forceinline__ unsigned cvt_pk_bf16(float lo, float hi) { unsigned r; asm volatile("v_cvt_pk_bf16_f32 %0, %1, %2" : "=v"(r) : "v"(lo), "v"(hi)); return r; }
typedef float f32x2 __attribute__((ext_vector_type(2)));
template <class Epi, class Sched, bool ALIGN_EPI = false, bool SP2 = false>
__device__ __forceinline__ void gemm_phase(PG8_LAS unsigned char* lds, const Gemm g, const Sched& S, const Epi& E) {
    const int tid = threadIdx.x, wid = __builtin_amdgcn_readfirstlane(tid >> 6), lane = tid & 63, wr = wid >> 2, wc = wid & 3, fr = lane & 15, fq = lane >> 4;
    const int K = g.K, nt = K / BK;
    unsigned voffA[2], voffB[2];
#pragma unroll
    for (int i = 0; i < 2; ++i) { int R, C; stage_rc(tid * 16 + i * 8192, R, C); const int Rb = Epi::PERM ? ((R & ~31) + perm32(R & 31)) : R;
        voffA[i] = (unsigned)(R * K + C) * 2u; voffB[i] = (unsigned)(Rb * K + C) * 2u; }
    const size_t kstep = (size_t)(BK * 2);
    const size_t hstep = (size_t)HALF * K * 2;
    const size_t tstep = 2 * hstep;
    const unsigned ldsw = (unsigned)wid * 1024u;
    const int aoff = lds_byte(wr * 64 + fr, fq * 8), boff = lds_byte(wc * 32 + fr, fq * 8);
#define PG8_SA(b, h) (((b) * 2 + (h)) * HTB)
#define PG8_SB(b, h) ((4 + (b) * 2 + (h)) * HTB)
#define PG8_STAGE(bufoff, gbase, voff) do { _Pragma("unroll") for (int _i = 0; _i < 2; ++_i) \
        __builtin_amdgcn_global_load_lds((const unsigned*)((const char*)(gbase) + (voff)[_i]), (PG8_LAS unsigned*)(lds + (bufoff) + ldsw + _i * 8192), 16, 0, 0); } while (0)
#define PG8_LDA(dst, b, h) do { _Pragma("unroll") for (int m = 0; m < 4; ++m) _Pragma("unroll") for (int k = 0; k < 2; ++k) dst[m][k] = *(const PG8_LAS bf16x8*)(lds + PG8_SA(b, h) + aoff + m * 2048 + k * 1024); } while (0)
#define PG8_LDB(dst, b, h) do { _Pragma("unroll") for (int n = 0; n < 2; ++n) _Pragma("unroll") for (int k = 0; k < 2; ++k) dst[n][k] = *(const PG8_LAS bf16x8*)(lds + PG8_SB(b, h) + boff + n * 2048 + k * 1024); } while (0)
#define PG8_MMA(ai, bj, At, Bt) do { __builtin_amdgcn_s_setprio(1); _Pragma("unroll") for (int m = 0; m < 4; ++m) _Pragma("unroll") for (int n = 0; n < 2; ++n) _Pragma("unroll") for (int k = 0; k < 2; ++k) \
        acc[ai][bj][m][n] = __builtin_amdgcn_mfma_f32_16x16x32_bf16(Bt[n][k], At[m][k], acc[ai][bj][m][n], 0, 0, 0); __builtin_amdgcn_s_setprio(0); } while (0)
#define PG8_WAIT_V(n) asm volatile("s_waitcnt vmcnt(" #n ")" ::: "memory")
#define PG8_WAIT_L(n) asm volatile("s_waitcnt lgkmcnt(" #n ")" ::: "memory")
#define PG8_BAR __builtin_amdgcn_s_barrier()
#define PG8_SCHED __builtin_amdgcn_sched_barrier(0)
    Unit cur, nxt; int ui = 0;
    if (!S.next(0, cur)) return;
    f32x4 acc[2][2][4][2];
#pragma unroll
    for (int a = 0; a < 2; ++a)
#pragma unroll
        for (int b = 0; b < 2; ++b)
#pragma unroll
            for (int m = 0; m < 4; ++m)
#pragma unroll
                for (int n = 0; n < 2; ++n) acc[a][b][m][n] = (f32x4){0.f, 0.f, 0.f, 0.f};
    bf16x8 At[4][2], B0[2][2], B1[2][2];
    const char* cA = (const char*)g.A + (size_t)cur.pm * tstep; const char* cB = (const char*)g.Bt + (size_t)cur.pn * tstep;
    S.a_ready(cur);
    if constexpr (SP2) {
        PG8_STAGE(PG8_SB(0, 0), cB, voffB); PG8_STAGE(PG8_SB(0, 1), cB + hstep, voffB); PG8_STAGE(PG8_SA(0, 0), cA, voffA); PG8_STAGE(PG8_SA(0, 1), cA + hstep, voffA);
        if (wr == 1) PG8_BAR;
        PG8_WAIT_V(2); PG8_BAR;
        PG8_STAGE(PG8_SB(1, 0), cB + kstep, voffB); PG8_STAGE(PG8_SA(1, 0), cA + kstep, voffA); PG8_STAGE(PG8_SB(1, 1), cB + hstep + kstep, voffB);
        PG8_WAIT_V(6); PG8_BAR;
    } else {
        PG8_STAGE(PG8_SB(0, 0), cB, voffB); PG8_STAGE(PG8_SA(0, 0), cA, voffA); PG8_STAGE(PG8_SB(0, 1), cB + hstep, voffB); PG8_STAGE(PG8_SA(0, 1), cA + hstep, voffA);
        if (wr == 1) PG8_BAR;
        PG8_WAIT_V(4); PG8_BAR;
        PG8_STAGE(PG8_SB(1, 0), cB + kstep, voffB); PG8_STAGE(PG8_SA(1, 0), cA + kstep, voffA); PG8_STAGE(PG8_SB(1, 1), cB + hstep + kstep, voffB);
        PG8_WAIT_V(6); PG8_BAR;
    }
    for (;;) {
        const bool has_next = S.next(ui + 1, nxt);
        const char* nA = has_next ? (const char*)g.A + (size_t)nxt.pm * tstep : cA; const char* nB = has_next ? (const char*)g.Bt + (size_t)nxt.pn * tstep : cB;
        for (int t = 0; t < nt; t += 2) {
            const bool last = (t == nt - 2);
            const char* a1 = cA + (size_t)(t + 1) * kstep;
            const char* a2 = last ? nA : cA + (size_t)(t + 2) * kstep; const char* b2 = last ? nB : cB + (size_t)(t + 2) * kstep;
            const char* a3 = a2 + kstep; const char* b3 = b2 + kstep;
            if (last && has_next) S.a_ready(nxt);
            if constexpr (SP2) {
            PG8_LDB(B0, 0, 0); PG8_LDB(B1, 0, 1); PG8_SCHED; PG8_LDA(At, 0, 0); PG8_STAGE(PG8_SA(1, 1), a1 + hstep, voffA);
            PG8_WAIT_V(8); PG8_WAIT_L(0); PG8_BAR; PG8_MMA(0, 0, At, B0); PG8_MMA(0, 1, At, B1); PG8_BAR; PG8_SCHED;
            PG8_LDA(At, 0, 1); PG8_STAGE(PG8_SB(0, 0), b2, voffB); PG8_STAGE(PG8_SB(0, 1), b2 + hstep, voffB); PG8_STAGE(PG8_SA(0, 0), a2, voffA);
            PG8_WAIT_V(8); PG8_WAIT_L(0); PG8_BAR; PG8_MMA(1, 0, At, B0); PG8_MMA(1, 1, At, B1); PG8_BAR; PG8_SCHED;
            PG8_LDB(B0, 1, 0); PG8_LDB(B1, 1, 1); PG8_SCHED; PG8_LDA(At, 1, 0); PG8_STAGE(PG8_SA(0, 1), a2 + hstep, voffA);
            PG8_WAIT_V(8); PG8_WAIT_L(0); PG8_BAR; PG8_MMA(0, 0, At, B0); PG8_MMA(0, 1, At, B1); PG8_BAR; PG8_SCHED;
            PG8_LDA(At, 1, 1); PG8_STAGE(PG8_SB(1, 0), b3, voffB); PG8_STAGE(PG8_SB(1, 1), b3 + hstep, voffB); PG8_STAGE(PG8_SA(1, 0), a3, voffA);
            PG8_WAIT_V(8); PG8_WAIT_L(0); PG8_BAR; PG8_MMA(1, 0, At, B0); PG8_MMA(1, 1, At, B1); PG8_BAR; PG8_SCHED;
            } else {
            PG8_LDB(B0, 0, 0); PG8_SCHED; PG8_LDA(At, 0, 0); PG8_STAGE(PG8_SA(1, 1), a1 + hstep, voffA);
            PG8_WAIT_L(8); PG8_BAR; PG8_WAIT_L(0); PG8_MMA(0, 0, At, B0); PG8_BAR; PG8_SCHED;
            PG8_LDB(B1, 0, 1); PG8_STAGE(PG8_SB(0, 0), b2, voffB);
            PG8_BAR; PG8_WAIT_L(0); PG8_MMA(0, 1, At, B1); PG8_BAR;
            PG8_LDA(At, 0, 1); PG8_STAGE(PG8_SA(0, 0), a2, voffA);
            PG8_BAR; PG8_WAIT_L(0); PG8_MMA(1, 0, At, B0); PG8_BAR; PG8_SCHED;
            PG8_STAGE(PG8_SB(0, 1), b2 + hstep, voffB);
            PG8_WAIT_V(6); PG8_BAR; PG8_MMA(1, 1, At, B1); PG8_BAR;
            PG8_LDB(B0, 1, 0); PG8_SCHED; PG8_LDA(At, 1, 0); PG8_STAGE(PG8_SA(0, 1), a2 + hstep, voffA);
            PG8_WAIT_L(8); PG8_BAR; PG8_WAIT_L(0); PG8_MMA(0, 0, At, B0); PG8_BAR; PG8_SCHED;
            PG8_LDB(B1, 1, 1); PG8_STAGE(PG8_SB(1, 0), b3, voffB);
            PG8_BAR; PG8_WAIT_L(0); PG8_MMA(0, 1, At, B1); PG8_BAR;
            PG8_LDA(At, 1, 1); PG8_STAGE(PG8_SA(1, 0), a3, voffA);
            PG8_BAR; PG8_WAIT_L(0); PG8_MMA(1, 0, At, B0); PG8_BAR; PG8_SCHED;
            PG8_STAGE(PG8_SB(1, 1), b3 + hstep, voffB);
            PG8_WAIT_V(6); PG8_BAR; PG8_MMA(1, 1, At, B1); PG8_BAR;
            }
        }
        if constexpr (ALIGN_EPI) { if (wr == 0) PG8_BAR; }
        if constexpr (!Epi::AFTER_DRAIN) { E(acc, cur, wr, wc, fr, fq); S.done(cur); }
        if (!has_next) break;
#pragma unroll
        for (int a = 0; a < 2; ++a)
#pragma unroll
            for (int b = 0; b < 2; ++b)
#pragma unroll
                for (int m = 0; m < 4; ++m)
#pragma unroll
                    for (int n = 0; n < 2; ++n) acc[a][b][m][n] = (f32x4){0.f, 0.f, 0.f, 0.f};
        cur = nxt; cA = nA; cB = nB; ++ui;
        if constexpr (ALIGN_EPI) { if (wr == 1) PG8_BAR; }
    }
    PG8_WAIT_V(0);
    if constexpr (!ALIGN_EPI) { if (wr == 0) PG8_BAR; }
    PG8_BAR;
    if constexpr (Epi::AFTER_DRAIN) { E.fused(acc, cur, wr, wc, fr, fq, lds, wid, lane); S.done(cur); }
#undef PG8_SA
#undef PG8_SB
#undef PG8_STAGE
#undef PG8_LDA
#undef PG8_LDB
#undef PG8_MMA
#undef PG8_WAIT_V
#undef PG8_WAIT_L
#undef PG8_BAR
#undef PG8_SCHED
}
}

using pg8::bf16_t; using pg8::bf16x8; using pg8::f32x4; using pg8::u32x4;
#define GAS __attribute__((address_space(1)))
#define LAS __attribute__((address_space(3)))
typedef unsigned v4u __attribute__((ext_vector_type(4)));
typedef unsigned u32x2 __attribute__((ext_vector_type(2)));
typedef float f32x16 __attribute__((ext_vector_type(16)));
typedef float f32x2_t __attribute__((ext_vector_type(2)));
typedef __bf16 bf16x2_t __attribute__((ext_vector_type(2)));
#define LDS_WAIT() asm volatile("s_waitcnt lgkmcnt(0)" ::: "memory")
__device__ __forceinline__ unsigned f2bf(float f) { unsigned u = __builtin_bit_cast(unsigned, f); return (u + 0x7fffu + ((u >> 16) & 1u)) >> 16; }
__device__ __forceinline__ unsigned pk2(float lo, float hi) { return f2bf(lo) | (f2bf(hi) << 16); }
__device__ __forceinline__ unsigned pkbf(float lo, float hi) { f32x2_t v = {lo, hi}; bf16x2_t b = __builtin_convertvector(v, bf16x2_t); return __builtin_bit_cast(unsigned, b); }
__device__ __forceinline__ float bflo(unsigned w) { return __uint_as_float(w << 16); }
__device__ __forceinline__ float bfhi(unsigned w) { return __uint_as_float(w & 0xffff0000u); }
__device__ __forceinline__ float wave_sum(float v) {
#pragma unroll
    for (int o = 1; o < 64; o <<= 1) v += __shfl_xor(v, o);
    return v;
}
__device__ __forceinline__ float wave_max(float v) {
#pragma unroll
    for (int o = 1; o < 64; o <<= 1) v = fmaxf(v, __shfl_xor(v, o));
    return v;
}
__device__ __forceinline__ float gelu_t(float x) {
    const float u = 0.7978845608028654f * (x + 0.044715f * x * x * x);
    return x * __builtin_amdgcn_rcpf(1.f + __expf(-2.f * u));
}
__device__ __forceinline__ float silu_f(float x) { return x * __builtin_amdgcn_rcpf(1.f + __expf(-x)); }

constexpr int DM = 1024, T = 16384, NB = 2, MP = NB * T, SBT = 8, STT = 16, MS = SBT * STT, DIN = 3584;
constexpr int SEG_U = 0, SEG_V = 512, SEG_G = 1024, SEG_Q = 1536, SEG_K = 2048, SEG_VV = 2560, SEG_GB = 3072;
constexpr float EPS = 1e-6f;
constexpr size_t OUT_YP = 0, OUT_YS = 33554432, OUT_KP = 33685504, OUT_VP = 34209792, OUT_KS = 34734080, OUT_VS = 34799616, OUT_GV = 34865152;
constexpr size_t MiB = 1u << 20;
constexpr size_t WS_MOD = 0, WS_WIN = 1 * MiB, WS_WOUT = 8 * MiB, WS_WST = 10 * MiB, WS_STATS = 11 * MiB, WS_XN = 16 * MiB, WS_ZB = 96 * MiB,
                 WS_GVT = 320 * MiB, WS_VT = 352 * MiB, WS_OB = 384 * MiB, WS_ZS = 448 * MiB, WS_OS = 450 * MiB, WS_END = 451 * MiB;
constexpr int LDS_BYTES = 147456;

struct P {
    const float *x_prompt, *x_sample, *cache_k, *cache_v, *c_prompt, *c_sample, *g_pre, *w_ada, *b_ada, *w_in, *ln_g, *ln_b, *w_s, *b_s, *rel_bias, *w_out, *g_post;
    float* out;
    float* MOD; bf16_t* WIN; bf16_t* WOUT; bf16_t* WST; float* STATS; bf16_t* XN; bf16_t* ZB; bf16_t* GVT; bf16_t* VT; bf16_t* OB; float* ZS; float* OS;
    int ph_lo, ph_hi;
};
__device__ __forceinline__ void p0_transpose_item(const float* W, int K, int N, bf16_t* WT, int row_off, LAS float* scr, int item, int lane) {
    const int nblk = N / 32, kb = item / nblk, nb = item % nblk, k0 = 64 * kb, n0 = 32 * nb;
#pragma unroll 8
    for (int i = 0; i < 32; ++i) { const int kk = 2 * i + (lane >> 5); scr[kk * 33 + (lane & 31)] = W[(size_t)(k0 + kk) * N + n0 + (lane & 31)]; }
    LDS_WAIT(); asm volatile("" ::: "memory");
    const int c = lane & 7;
#pragma unroll
    for (int j = 0; j < 4; ++j) { const int n = (lane >> 3) + 8 * j; const LAS float* s = scr + (8 * c) * 33 + n;
        v4u o; o.x = pk2(s[0 * 33], s[1 * 33]); o.y = pk2(s[2 * 33], s[3 * 33]); o.z = pk2(s[4 * 33], s[5 * 33]); o.w = pk2(s[6 * 33], s[7 * 33]);
        *(GAS v4u*)(WT + (size_t)(row_off + n0 + n) * K + k0 + 8 * c) = o; }
    LDS_WAIT(); asm volatile("" ::: "memory");
}
__device__ __forceinline__ void phase0(const P& p, LAS unsigned char* lds, int tid, int wave, int lane) {
    if (blockIdx.x < 192) {
        LAS float* sc = (LAS float*)lds;
        LAS float* red = sc + 10240;
        for (int i = tid; i < 10240; i += 512) { const int b = i >> 10, k = i & 1023; const float c = b < 2 ? p.c_prompt[b * 1024 + k] : p.c_sample[(b - 2) * 1024 + k]; sc[i] = silu_f(c); }
        __syncthreads();
        const int j0 = blockIdx.x * 16, j = lane & 15, ks = lane >> 4;
        float acc[10];
#pragma unroll
        for (int b = 0; b < 10; ++b) acc[b] = 0.f;
#pragma unroll 4
        for (int i = 0; i < 32; ++i) { const int k = wave * 128 + i * 4 + ks; const float w = p.w_ada[(size_t)k * 3072 + j0 + j];
#pragma unroll
            for (int b = 0; b < 10; ++b) acc[b] += sc[b * 1024 + k] * w; }
#pragma unroll
        for (int b = 0; b < 10; ++b) { acc[b] += __shfl_xor(acc[b], 16); acc[b] += __shfl_xor(acc[b], 32); }
        if (lane < 16) {
#pragma unroll
            for (int b = 0; b < 10; ++b) red[(wave * 10 + b) * 16 + j] = acc[b]; }
        __syncthreads();
        if (tid < 160) { const int b = tid >> 4, jj = tid & 15; float s = p.b_ada[j0 + jj];
#pragma unroll
            for (int w = 0; w < 8; ++w) s += red[(w * 10 + b) * 16 + jj];
            p.MOD[b * 3072 + j0 + jj] = s; }
        __syncthreads();
    }
    LAS float* scr = (LAS float*)(lds + wave * 16384);
    const int gw = blockIdx.x * 8 + wave, NGW = gridDim.x * 8;
    constexpr int I_IN = (DM / 64) * (DIN / 32), I_OUT = (DM / 64) * (DM / 32);
    for (int it = gw; it < I_IN + I_OUT; it += NGW) {
        if (it < I_IN) p0_transpose_item(p.w_in, DM, DIN, p.WIN, 0, scr, it, lane);
        else p0_transpose_item(p.w_out, DM, DM, p.WOUT, 0, scr, it - I_IN, lane);
    }
    for (int i = blockIdx.x * 512 + tid; i < 8 * 128 * 128; i += gridDim.x * 512) { const int t = (i >> 7) & 127, s = i & 127; p.WST[i] = (bf16_t)f2bf(s <= t ? p.w_s[i] : 0.f); }
}

__device__ __forceinline__ void phase1(const P& p, int wave, int lane) {
    const int gw = blockIdx.x * 8 + wave, NGW = gridDim.x * 8;
    for (int m = gw; m < MP + MS; m += NGW) {
        const float* xrow; int b;
        if (m < MP) { xrow = p.x_prompt + (size_t)m * DM; b = m >> 14; } else { xrow = p.x_sample + (size_t)(m - MP) * DM; b = 2 + ((m - MP) >> 4); }
        const f32x4* xr = (const f32x4*)xrow + lane;
        f32x4 v[4]; float s = 0.f;
#pragma unroll
        for (int j = 0; j < 4; ++j) { v[j] = xr[64 * j]; s += (v[j].x * v[j].x + v[j].y * v[j].y) + (v[j].z * v[j].z + v[j].w * v[j].w); }
        const float rstd = rsqrtf(wave_sum(s) * (1.f / DM) + EPS);
        const float* mod = p.MOD + b * 3072;
        u32x2* o8 = (u32x2*)(p.XN + (size_t)m * DM) + lane;
#pragma unroll
        for (int j = 0; j < 4; ++j) { const int c = 4 * lane + 256 * j;
            const f32x4 g = *(const f32x4*)(p.g_pre + c), sh = *(const f32x4*)(mod + c), sl = *(const f32x4*)(mod + 1024 + c);
            const f32x4 hh = v[j] * rstd * g * (sl + 1.f) + sh;
            u32x2 w; w.x = pkbf(hh.x, hh.y); w.y = pkbf(hh.z, hh.w); o8[64 * j] = w; }
    }
}

struct EpiIn {
    static constexpr bool PERM = true, AFTER_DRAIN = false;
    bf16_t* ZB; bf16_t* GVT; bf16_t* VT; float* STATS; float* outK; float* outV;
    __device__ __forceinline__ void operator()(const f32x4 (&acc)[2][2][4][2], const pg8::Unit& u, int wr, int wc, int fr, int fq) const {
        const int seg = u.pn >> 1, cs0 = (u.pn & 1) * 256 + wc * 32 + 8 * fq, row0 = u.pm * 256 + wr * 64 + fr;
        if (seg == 1 || seg == 5) {
            bf16_t* dstT = (seg == 1) ? GVT : VT;
#pragma unroll
            for (int ai = 0; ai < 2; ++ai)
#pragma unroll
                for (int m = 0; m < 4; ++m) { const int row = row0 + ai * 128 + m * 16, b = row >> 14, t = row & (T - 1);
                    float s1 = 0.f, s2 = 0.f;
#pragma unroll
                    for (int bj = 0; bj < 2; ++bj) { const int cs = cs0 + bj * 128; float v[8];
#pragma unroll
                        for (int i = 0; i < 4; ++i) { v[i] = acc[ai][bj][m][0][i]; v[4 + i] = acc[ai][bj][m][1][i]; }
                        if (seg == 1) {
#pragma unroll
                            for (int i = 0; i < 8; ++i) { v[i] = gelu_t(v[i]); s1 += v[i]; s2 += v[i] * v[i]; } }
                        else if (t >= T - 512) { float* o = outV + ((size_t)(b * 512 + t - (T - 512))) * 512 + cs;
                            *(f32x4*)o = (f32x4){v[0], v[1], v[2], v[3]}; *(f32x4*)(o + 4) = (f32x4){v[4], v[5], v[6], v[7]}; }
                        bf16_t* d = dstT + ((size_t)(b * 512 + cs)) * T + t;
#pragma unroll
                        for (int i = 0; i < 4; ++i) { const unsigned w = pkbf(v[2 * i], v[2 * i + 1]); d[(size_t)(2 * i) * T] = (bf16_t)(w & 0xffffu); d[(size_t)(2 * i + 1) * T] = (bf16_t)(w >> 16); }
                    }
                    if (seg == 1) { s1 += __shfl_xor(s1, 16); s1 += __shfl_xor(s1, 32); s2 += __shfl_xor(s2, 16); s2 += __shfl_xor(s2, 32);
                        if (fq == 0) { f32x2_t sv = {s1, s2}; *(f32x2_t*)(STATS + (size_t)row * 16 + ((u.pn & 1) * 4 + wc) * 2) = sv; } }
                }
        } else {
#pragma unroll
            for (int ai = 0; ai < 2; ++ai)
#pragma unroll
                for (int m = 0; m < 4; ++m) { const int row = row0 + ai * 128 + m * 16, b = row >> 14, t = row & (T - 1);
#pragma unroll
                    for (int bj = 0; bj < 2; ++bj) { const int cs = cs0 + bj * 128; float v[8];
#pragma unroll
                        for (int i = 0; i < 4; ++i) { v[i] = acc[ai][bj][m][0][i]; v[4 + i] = acc[ai][bj][m][1][i]; }
                        if (seg == 0) {
#pragma unroll
                            for (int i = 0; i < 8; ++i) v[i] = gelu_t(v[i]); }
                        else if (seg == 2 || seg == 6) {
#pragma unroll
                            for (int i = 0; i < 8; ++i) v[i] = silu_f(v[i]); }
                        else if (seg == 3) {
#pragma unroll
                            for (int i = 0; i < 8; ++i) v[i] *= 0.125f; }
                        else if (t >= T - 512) { float* o = outK + ((size_t)(b * 512 + t - (T - 512))) * 512 + cs;
                            *(f32x4*)o = (f32x4){v[0], v[1], v[2], v[3]}; *(f32x4*)(o + 4) = (f32x4){v[4], v[5], v[6], v[7]}; }
                        u32x4 w; w.x = pkbf(v[0], v[1]); w.y = pkbf(v[2], v[3]); w.z = pkbf(v[4], v[5]); w.w = pkbf(v[6], v[7]);
                        *(u32x4*)(ZB + (size_t)row * DIN + seg * 512 + cs) = w; }
                }
        }
    }
};
struct EpiOut {
    static constexpr bool PERM = true, AFTER_DRAIN = false;
    bf16_t* O;
    __device__ __forceinline__ void operator()(const f32x4 (&acc)[2][2][4][2], const pg8::Unit& u, int wr, int wc, int fr, int fq) const {
        const int c0 = u.pn * 256 + wc * 32 + 8 * fq, row0 = u.pm * 256 + wr * 64 + fr;
#pragma unroll
        for (int ai = 0; ai < 2; ++ai)
#pragma unroll
            for (int m = 0; m < 4; ++m) { const int row = row0 + ai * 128 + m * 16;
#pragma unroll
                for (int bj = 0; bj < 2; ++bj) { const f32x4 v0 = acc[ai][bj][m][0], v1 = acc[ai][bj][m][1];
                    u32x4 w; w.x = pkbf(v0[0], v0[1]); w.y = pkbf(v0[2], v0[3]); w.z = pkbf(v1[0], v1[1]); w.w = pkbf(v1[2], v1[3]);
                    *(u32x4*)(O + (size_t)row * DM + c0 + bj * 128) = w; } }
    }
};

__device__ __forceinline__ f32x4 small_gemm(const bf16_t* A, const bf16_t* Bt, int n0, int wave, int lane) {
    const int fr = lane & 15, fq = lane >> 4;
    const bf16x8* ap = (const bf16x8*)(A + (size_t)(wave * 16 + fr) * DM + 8 * fq);
    const bf16x8* bp = (const bf16x8*)(Bt + (size_t)(n0 + fr) * DM + 8 * fq);
    f32x4 acc = {0.f, 0.f, 0.f, 0.f};
#pragma unroll 8
    for (int ks = 0; ks < 32; ++ks) acc = __builtin_amdgcn_mfma_f32_16x16x32_bf16(bp[ks * 4], ap[ks * 4], acc, 0, 0, 0);
    return acc;
}
#define MFMA32(a, b, c) __builtin_amdgcn_mfma_f32_32x32x16_bf16((a), (b), (c), 0, 0, 0)
__device__ __forceinline__ void attn_unit(const P& p, int b, int h, int ci, const LAS float* biasL, int lane) {
    const int r = lane & 31, h2 = lane >> 5;
    const size_t rowbase = (size_t)b * T;
    bf16x8 qf[2][4];
#pragma unroll
    for (int qt = 0; qt < 2; ++qt)
#pragma unroll
        for (int ks = 0; ks < 4; ++ks) qf[qt][ks] = *(const bf16x8*)(p.ZB + (rowbase + ci * 64 + qt * 32 + r) * DIN + SEG_Q + h * 64 + 16 * ks + 8 * h2);
    f32x16 o[2][2];
#pragma unroll
    for (int dt = 0; dt < 2; ++dt)
#pragma unroll
        for (int qt = 0; qt < 2; ++qt)
#pragma unroll
            for (int i = 0; i < 16; ++i) o[dt][qt][i] = 0.f;
    float m_used[2] = {-1e30f, -1e30f}, lsum[2] = {0.f, 0.f};
    const int cj0 = ci > 8 ? ci - 8 : 0, nblk = (ci - cj0 + 1) * 2, key_start = cj0 * 64;
    const bf16_t* kbase = p.ZB + (rowbase + key_start + r) * DIN + SEG_K + h * 64 + 8 * h2;
    const bf16_t* vbase = p.VT + ((size_t)(b * 512 + h * 64 + r)) * T + key_start + 4 * h2;
    bf16x8 kf[4];
#pragma unroll
    for (int ks = 0; ks < 4; ++ks) kf[ks] = *(const bf16x8*)(kbase + 16 * ks);
    for (int blk = 0; blk < nblk; ++blk) {
        const int key0 = key_start + blk * 32;
        u32x2 vv[2][2][2];
#pragma unroll
        for (int dt = 0; dt < 2; ++dt)
#pragma unroll
            for (int s = 0; s < 2; ++s)
#pragma unroll
                for (int e = 0; e < 2; ++e) vv[dt][s][e] = *(const u32x2*)(vbase + (size_t)(dt * 32) * T + blk * 32 + 16 * s + 8 * e);
        const int nb = blk + 1 < nblk ? blk + 1 : blk;
        bf16x8 kn[4];
#pragma unroll
        for (int ks = 0; ks < 4; ++ks) kn[ks] = *(const bf16x8*)(kbase + (size_t)(nb * 32) * DIN + 16 * ks);
        f32x16 s[2];
#pragma unroll
        for (int qt = 0; qt < 2; ++qt) {
#pragma unroll
            for (int i = 0; i < 16; ++i) s[qt][i] = 0.f;
#pragma unroll
            for (int ks = 0; ks < 4; ++ks) s[qt] = MFMA32(kf[ks], qf[qt][ks], s[qt]); }
        if (key0 + 31 + 128 <= ci * 64) { const float bc = biasL[256];
#pragma unroll
            for (int qt = 0; qt < 2; ++qt)
#pragma unroll
                for (int i = 0; i < 16; ++i) s[qt][i] += bc;
        } else {
#pragma unroll
            for (int qt = 0; qt < 2; ++qt)
#pragma unroll
                for (int i = 0; i < 16; ++i) { const int key = key0 + (i & 3) + 8 * (i >> 2) + 4 * h2; int dist = ci * 64 + qt * 32 + r - key; dist = dist < -128 ? -128 : (dist > 128 ? 128 : dist); s[qt][i] += biasL[dist + 128]; }
        }
        float mx[2];
#pragma unroll
        for (int qt = 0; qt < 2; ++qt) { float a = s[qt][0];
#pragma unroll
            for (int i = 1; i < 16; ++i) a = fmaxf(a, s[qt][i]);
            mx[qt] = fmaxf(a, __shfl_xor(a, 32)); }
        const bool need = (mx[0] > m_used[0] + 8.f) || (mx[1] > m_used[1] + 8.f);
        if (__builtin_amdgcn_ballot_w64(need) != 0ull) {
#pragma unroll
            for (int qt = 0; qt < 2; ++qt) { const float mnew = fmaxf(m_used[qt], mx[qt]), alpha = __expf(m_used[qt] - mnew); lsum[qt] *= alpha; m_used[qt] = mnew;
#pragma unroll
                for (int dt = 0; dt < 2; ++dt)
#pragma unroll
                    for (int i = 0; i < 16; ++i) o[dt][qt][i] *= alpha; }
        }
        bf16x8 pf[2][2];
#pragma unroll
        for (int qt = 0; qt < 2; ++qt) {
#pragma unroll
            for (int i = 0; i < 16; ++i) { const float e = __expf(s[qt][i] - m_used[qt]); s[qt][i] = e; lsum[qt] += e; }
#pragma unroll
            for (int sp = 0; sp < 2; ++sp) { u32x4 w; w.x = pkbf(s[qt][8 * sp], s[qt][8 * sp + 1]); w.y = pkbf(s[qt][8 * sp + 2], s[qt][8 * sp + 3]); w.z = pkbf(s[qt][8 * sp + 4], s[qt][8 * sp + 5]); w.w = pkbf(s[qt][8 * sp + 6], s[qt][8 * sp + 7]);
                pf[qt][sp] = __builtin_bit_cast(bf16x8, w); } }
#pragma unroll
        for (int dt = 0; dt < 2; ++dt)
#pragma unroll
            for (int sp = 0; sp < 2; ++sp) { u32x4 w; w.x = vv[dt][sp][0].x; w.y = vv[dt][sp][0].y; w.z = vv[dt][sp][1].x; w.w = vv[dt][sp][1].y; const bf16x8 vf = __builtin_bit_cast(bf16x8, w);
#pragma unroll
                for (int qt = 0; qt < 2; ++qt) o[dt][qt] = MFMA32(vf, pf[qt][sp], o[dt][qt]); }
#pragma unroll
        for (int ks = 0; ks < 4; ++ks) kf[ks] = kn[ks];
    }
#pragma unroll
    for (int qt = 0; qt < 2; ++qt) { const float l = lsum[qt] + __shfl_xor(lsum[qt], 32), inv = 1.f / l; const size_t row = rowbase + ci * 64 + qt * 32 + r;
#pragma unroll
        for (int dt = 0; dt < 2; ++dt)
#pragma unroll
            for (int g4 = 0; g4 < 4; ++g4) { const int d = 32 * dt + 8 * g4 + 4 * h2;
                const u32x2 gb = *(const u32x2*)(p.ZB + row * DIN + SEG_GB + h * 64 + d);
                u32x2 w; w.x = pkbf(o[dt][qt][4 * g4] * inv * bflo(gb.x), o[dt][qt][4 * g4 + 1] * inv * bfhi(gb.x)); w.y = pkbf(o[dt][qt][4 * g4 + 2] * inv * bflo(gb.y), o[dt][qt][4 * g4 + 3] * inv * bfhi(gb.y));
                *(u32x2*)(p.XN + row * DM + 512 + h * 64 + d) = w; } }
}

__device__ __forceinline__ void gmlp_unit(const P& p, int b, int n, int g, LAS float* scr, int lane) {
    const int r = lane & 31, h2 = lane >> 5;
    const size_t rowbase = (size_t)b * T + n * 128;
#pragma unroll
    for (int e = 0; e < 2; ++e) { const int tl = lane + 64 * e; const f32x4* sp = (const f32x4*)(p.STATS + (rowbase + tl) * 16);
        const f32x4 a0 = sp[0], a1 = sp[1], a2 = sp[2], a3 = sp[3];
        const float s1 = ((a0.x + a0.z) + (a1.x + a1.z)) + ((a2.x + a2.z) + (a3.x + a3.z)), s2 = ((a0.y + a0.w) + (a1.y + a1.w)) + ((a2.y + a2.w) + (a3.y + a3.w));
        const float mean = s1 * (1.f / 512.f), var = fmaxf(s2 * (1.f / 512.f) - mean * mean, 0.f), rstd = rsqrtf(var + EPS);
        f32x2_t sv = {rstd, -mean * rstd}; *(LAS f32x2_t*)(scr + tl * 2) = sv; }
    float lg[2], lb[2];
#pragma unroll
    for (int dt = 0; dt < 2; ++dt) { lg[dt] = p.ln_g[g * 64 + 32 * dt + r]; lb[dt] = p.ln_b[g * 64 + 32 * dt + r]; }
    f32x16 acc[2][4];
#pragma unroll
    for (int dt = 0; dt < 2; ++dt)
#pragma unroll
        for (int tt = 0; tt < 4; ++tt)
#pragma unroll
            for (int i = 0; i < 16; ++i) acc[dt][tt][i] = 0.f;
    const bf16_t* abase = p.GVT + ((size_t)(b * 512 + g * 64 + r)) * T + n * 128 + 8 * h2;
    const bf16_t* wbase = p.WST + ((size_t)(g * 128 + r)) * 128 + 8 * h2;
#pragma unroll
    for (int ks = 0; ks < 8; ++ks) {
        f32x4 st[4];
#pragma unroll
        for (int i = 0; i < 4; ++i) st[i] = *(const LAS f32x4*)(scr + (16 * ks + 8 * h2) * 2 + 4 * i);
        bf16x8 af[2];
#pragma unroll
        for (int dt = 0; dt < 2; ++dt) { const u32x4 raw = *(const u32x4*)(abase + (size_t)(dt * 32) * T + 16 * ks); u32x4 w;
#pragma unroll
            for (int i = 0; i < 4; ++i) { const float x0 = bflo(raw[i]), x1 = bfhi(raw[i]);
                const float y0 = x0 * (st[i].x * lg[dt]) + (st[i].y * lg[dt] + lb[dt]), y1 = x1 * (st[i].z * lg[dt]) + (st[i].w * lg[dt] + lb[dt]); w[i] = pkbf(y0, y1); }
            af[dt] = __builtin_bit_cast(bf16x8, w); }
#pragma unroll
        for (int tt = 0; tt < 4; ++tt) if (ks <= 2 * tt + 1) { const bf16x8 wf = *(const bf16x8*)(wbase + (size_t)(tt * 32) * 128 + 16 * ks);
#pragma unroll
            for (int dt = 0; dt < 2; ++dt) acc[dt][tt] = MFMA32(af[dt], wf, acc[dt][tt]); }
    }
#pragma unroll
    for (int tt = 0; tt < 4; ++tt) { const int tl = 32 * tt + r; const size_t row = rowbase + tl; const float bs = p.b_s[g * 128 + tl];
#pragma unroll
        for (int dt = 0; dt < 2; ++dt)
#pragma unroll
            for (int g4 = 0; g4 < 4; ++g4) { const int c = g * 64 + 32 * dt + 8 * g4 + 4 * h2;
                const u32x2 uu = *(const u32x2*)(p.ZB + row * DIN + SEG_U + c), sg = *(const u32x2*)(p.ZB + row * DIN + SEG_G + c);
                u32x2 w; w.x = pkbf(bflo(uu.x) * (acc[dt][tt][4 * g4] + bs) * bflo(sg.x), bfhi(uu.x) * (acc[dt][tt][4 * g4 + 1] + bs) * bfhi(sg.x));
                w.y = pkbf(bflo(uu.y) * (acc[dt][tt][4 * g4 + 2] + bs) * bflo(sg.y), bfhi(uu.y) * (acc[dt][tt][4 * g4 + 3] + bs) * bfhi(sg.y));
                *(u32x2*)(p.XN + row * DM + c) = w; } }
}

__device__ __forceinline__ void sgmlp_unit(const P& p, int b, int g, int lane) {
    const int c = g * 64 + lane; const float lgc = p.ln_g[c], lbc = p.ln_b[c];
    float vn[16];
#pragma unroll
    for (int s = 0; s < 16; ++s) { const int row = b * 16 + s; const float* zr = p.ZS + (size_t)row * DIN + SEG_V;
        const f32x4 a = *(const f32x4*)(zr + 4 * lane), bq = *(const f32x4*)(zr + 256 + 4 * lane);
        const float mean = wave_sum((a.x + a.y) + (a.z + a.w) + (bq.x + bq.y) + (bq.z + bq.w)) * (1.f / 512.f);
        const f32x4 da = a - mean, db = bq - mean;
        const float var = wave_sum((da.x * da.x + da.y * da.y) + (da.z * da.z + da.w * da.w) + (db.x * db.x + db.y * db.y) + (db.z * db.z + db.w * db.w)) * (1.f / 512.f);
        vn[s] = (zr[c] - mean) * rsqrtf(var + EPS) * lgc + lbc;
        p.out[OUT_GV + (size_t)row * 512 + c] = vn[s]; }
#pragma unroll
    for (int t = 0; t < 16; ++t) { float acc = 0.f;
#pragma unroll
        for (int s = 0; s <= t; ++s) acc += p.w_s[(size_t)g * 16384 + t * 128 + s] * vn[s];
        const int row = b * 16 + t; const float* zr = p.ZS + (size_t)row * DIN;
        const float y = zr[SEG_U + c] * (acc + p.b_s[g * 128 + t]) * zr[SEG_G + c];
        p.XN[(size_t)(MP + row) * DM + c] = (bf16_t)f2bf(y); }
}
__device__ __forceinline__ void sattn_unit(const P& p, int b, int h, int t, LAS float* pscr, const LAS float* biasL, int lane) {
    const int row = b * 16 + t;
    const f32x4* qp = (const f32x4*)(p.ZS + (size_t)row * DIN + SEG_Q + h * 64);
    f32x4 q[16];
#pragma unroll
    for (int i = 0; i < 16; ++i) q[i] = qp[i];
    float mx = -1e30f;
#pragma unroll 1
    for (int i = 0; i < 9; ++i) { const int kk = lane + 64 * i; float s = -1e30f;
        if (kk < 528) { const float* kp = kk < 512 ? p.cache_k + (((size_t)b * 512 + kk) * 8 + h) * 64 : p.ZS + (size_t)(b * 16 + kk - 512) * DIN + SEG_K + h * 64;
            float a = 0.f;
#pragma unroll
            for (int j = 0; j < 16; ++j) { const f32x4 kv = ((const f32x4*)kp)[j]; a += (q[j].x * kv.x + q[j].y * kv.y) + (q[j].z * kv.z + q[j].w * kv.w); }
            int dist = 512 + t - kk; dist = dist > 128 ? 128 : (dist < -128 ? -128 : dist);
            s = a + biasL[dist + 128]; }
        pscr[kk] = s; mx = fmaxf(mx, s); }
    mx = wave_max(mx);
    float l = 0.f;
#pragma unroll 1
    for (int i = 0; i < 9; ++i) { const int kk = lane + 64 * i; const float e = kk < 528 ? __expf(pscr[kk] - mx) : 0.f; l += e; pscr[kk] = e; }
    l = wave_sum(l);
    float acc = 0.f;
    const float* vp = p.cache_v + (((size_t)b * 512) * 8 + h) * 64 + lane;
#pragma unroll 8
    for (int kk = 0; kk < 512; ++kk) acc += pscr[kk] * vp[(size_t)kk * 512];
#pragma unroll
    for (int kk = 0; kk < 16; ++kk) acc += pscr[512 + kk] * p.ZS[(size_t)(b * 16 + kk) * DIN + SEG_VV + h * 64 + lane];
    const float y = acc / l * p.ZS[(size_t)row * DIN + SEG_GB + h * 64 + lane];
    p.XN[(size_t)(MP + row) * DM + 512 + h * 64 + lane] = (bf16_t)f2bf(y);
}

__device__ __forceinline__ void phase5(const P& p, int wave, int lane) {
    const int gw = blockIdx.x * 8 + wave, NGW = gridDim.x * 8;
    for (int m = gw; m < MP + MS; m += NGW) {
        float o[16]; const float* xrow; float* yrow; int b;
        if (m < MP) { b = m >> 14; xrow = p.x_prompt + (size_t)m * DM; yrow = p.out + OUT_YP + (size_t)m * DM;
#pragma unroll
            for (int j = 0; j < 2; ++j) { const u32x4 w = *(const u32x4*)(p.OB + (size_t)m * DM + 8 * lane + 512 * j);
#pragma unroll
                for (int i = 0; i < 4; ++i) { o[8 * j + 2 * i] = bflo(w[i]); o[8 * j + 2 * i + 1] = bfhi(w[i]); } }
        } else { const int ms = m - MP; b = 2 + (ms >> 4); xrow = p.x_sample + (size_t)ms * DM; yrow = p.out + OUT_YS + (size_t)ms * DM;
#pragma unroll
            for (int j = 0; j < 2; ++j)
#pragma unroll
                for (int i = 0; i < 2; ++i) { const f32x4 w = *(const f32x4*)(p.OS + (size_t)ms * DM + 8 * lane + 512 * j + 4 * i); o[8 * j + 4 * i] = w.x; o[8 * j + 4 * i + 1] = w.y; o[8 * j + 4 * i + 2] = w.z; o[8 * j + 4 * i + 3] = w.w; }
        }
        float ss = 0.f;
#pragma unroll
        for (int i = 0; i < 16; ++i) ss += o[i] * o[i];
        const float rstd = rsqrtf(wave_sum(ss) * (1.f / DM) + EPS);
        const float* gate = p.MOD + b * 3072 + 2048;
#pragma unroll
        for (int j = 0; j < 2; ++j)
#pragma unroll
            for (int i = 0; i < 2; ++i) { const int c = 8 * lane + 512 * j + 4 * i;
                const f32x4 xv = *(const f32x4*)(xrow + c), gt = *(const f32x4*)(gate + c), gp = *(const f32x4*)(p.g_post + c);
                const f32x4 ov = {o[8 * j + 4 * i], o[8 * j + 4 * i + 1], o[8 * j + 4 * i + 2], o[8 * j + 4 * i + 3]};
                *(f32x4*)(yrow + c) = xv + gt * (ov * rstd * gp); }
    }
}
__global__ void __launch_bounds__(512, 2) hymba_fwd(P p) {
    extern __shared__ __attribute__((aligned(16))) unsigned char lds_raw[];
    cg::grid_group grid = cg::this_grid();
    LAS unsigned char* lds = (LAS unsigned char*)lds_raw;
    const int tid = threadIdx.x, lane = tid & 63, wave = __builtin_amdgcn_readfirstlane(tid >> 6);
    const int lo = p.ph_lo, hi = p.ph_hi;
#define IN(k) (lo <= (k) && (k) < hi)
#define SEAM(k) do { if (IN(k) && IN((k) + 1)) grid.sync(); } while (0)
#ifndef NO_P0
    if (IN(0)) phase0(p, lds, tid, wave, lane);
#endif
    SEAM(0);
#ifndef NO_P1
    if (IN(1)) phase1(p, wave, lane);
#endif
    SEAM(1);
#ifndef NO_P2
    if (IN(2)) {
        pg8::Gemm g{p.XN, p.WIN, MP, DIN, DM}; pg8::StaticOrder S; S.init(MP, DIN, (int)gridDim.x, (int)blockIdx.x);
        EpiIn E{p.ZB, p.GVT, p.VT, p.STATS, p.out + OUT_KP, p.out + OUT_VP};
        pg8::gemm_phase<EpiIn, pg8::StaticOrder, true, true>(lds, g, S, E);
        for (int un = blockIdx.x; un < DIN / 16; un += gridDim.x) {
            const int n0 = un * 16; const f32x4 a = small_gemm(p.XN + (size_t)MP * DM, p.WIN, n0, wave, lane);
            const int row = wave * 16 + (lane & 15), c = n0 + 4 * (lane >> 4), seg = c >> 9; float v[4] = {a[0], a[1], a[2], a[3]};
            if (seg <= 1) {
#pragma unroll
                for (int i = 0; i < 4; ++i) v[i] = gelu_t(v[i]); }
            else if (seg == 2 || seg == 6) {
#pragma unroll
                for (int i = 0; i < 4; ++i) v[i] = silu_f(v[i]); }
            else if (seg == 3) {
#pragma unroll
                for (int i = 0; i < 4; ++i) v[i] *= 0.125f; }
            const f32x4 vv = {v[0], v[1], v[2], v[3]};
            *(f32x4*)(p.ZS + (size_t)row * DIN + c) = vv;
            if (seg == 4) *(f32x4*)(p.out + OUT_KS + (size_t)row * 512 + (c - SEG_K)) = vv;
            if (seg == 5) *(f32x4*)(p.out + OUT_VS + (size_t)row * 512 + (c - SEG_VV)) = vv;
        }
    }
#endif
    SEAM(2);
    if (IN(3)) {
        LAS float* biasL = (LAS float*)lds;
        for (int i = tid; i < 8 * 257; i += 512) biasL[i] = p.rel_bias[i];
        __syncthreads();
        LAS float* wscr = (LAS float*)(lds + 16384 + wave * 4096);
        const int gw = blockIdx.x * 8 + wave, NGW = gridDim.x * 8;
#ifndef NO_SG
        for (int un = gw; un < 64; un += NGW) sgmlp_unit(p, un >> 3, un & 7, lane);
#endif
#ifndef NO_SA
        for (int un = gw; un < 1024; un += NGW) { const int h = (un >> 4) & 7; sattn_unit(p, un >> 7, h, un & 15, wscr, biasL + h * 257, lane); }
#endif
#ifndef NO_AT
        for (int un = gw; un < NB * 8 * 256; un += NGW) { const int ci = un & 255, h = (un >> 8) & 7, b = un >> 11; attn_unit(p, b, h, ci, biasL + h * 257, lane); }
#endif
#ifndef NO_GM
        for (int un = gw; un < NB * 128 * 8; un += NGW) { const int n = un & 127, g = (un >> 7) & 7, b = un >> 10; gmlp_unit(p, b, n, g, wscr, lane); }
#endif
    }
    SEAM(3);
#ifndef NO_P4
    if (IN(4)) {
        pg8::Gemm g{p.XN, p.WOUT, MP, DM, DM}; pg8::StaticOrder S; S.init(MP, DM, (int)gridDim.x, (int)blockIdx.x);
        EpiOut E{p.OB};
        pg8::gemm_phase<EpiOut, pg8::StaticOrder, true, true>(lds, g, S, E);
        for (int un = blockIdx.x; un < DM / 16; un += gridDim.x) {
            const int n0 = un * 16; const f32x4 a = small_gemm(p.XN + (size_t)MP * DM, p.WOUT, n0, wave, lane);
            *(f32x4*)(p.OS + (size_t)(wave * 16 + (lane & 15)) * DM + n0 + 4 * (lane >> 4)) = a;
        }
    }
#endif
    SEAM(4);
#ifndef NO_P5
    if (IN(5)) phase5(p, wave, lane);
#endif
#undef IN
#undef SEAM
}

#ifndef N_LAUNCHES
#define N_LAUNCHES 1
#endif
extern "C" void kernel_launch(void* const* d_in, const int* in_sizes, int n_in, void* d_out, int out_size, void* d_ws, size_t ws_size, hipStream_t stream) {
    static int grid = 0;
    if (grid == 0) {
        if (n_in != 17 || ws_size < WS_END) { fprintf(stderr, "kernel_launch: unexpected n_in %d / ws %zu\n", n_in, ws_size); grid = -1; return; }
        int dev = 0, cus = 0, per_cu = 0;
        if (hipGetDevice(&dev) != hipSuccess || hipDeviceGetAttribute(&cus, hipDeviceAttributeMultiprocessorCount, dev) != hipSuccess) { grid = -1; return; }
        if (hipFuncSetAttribute((const void*)hymba_fwd, hipFuncAttributeMaxDynamicSharedMemorySize, LDS_BYTES) != hipSuccess) { fprintf(stderr, "kernel_launch: hipFuncSetAttribute failed\n"); grid = -1; return; }
        if (hipOccupancyMaxActiveBlocksPerMultiprocessor(&per_cu, (const void*)hymba_fwd, 512, LDS_BYTES) != hipSuccess || per_cu < 1) { fprintf(stderr, "kernel_launch: occupancy query says %d\n", per_cu); grid = -1; return; }
        grid = cus;
    }
    if (grid < 0) return;
    P p{};
    const float** in = (const float**)&p.x_prompt;
    for (int i = 0; i < 17; ++i) in[i] = (const float*)d_in[i];
    unsigned char* ws = (unsigned char*)d_ws;
    p.out = (float*)d_out;
    p.MOD = (float*)(ws + WS_MOD); p.WIN = (bf16_t*)(ws + WS_WIN); p.WOUT = (bf16_t*)(ws + WS_WOUT); p.WST = (bf16_t*)(ws + WS_WST); p.STATS = (float*)(ws + WS_STATS);
    p.XN = (bf16_t*)(ws + WS_XN); p.ZB = (bf16_t*)(ws + WS_ZB); p.GVT = (bf16_t*)(ws + WS_GVT); p.VT = (bf16_t*)(ws + WS_VT); p.OB = (bf16_t*)(ws + WS_OB);
    p.ZS = (float*)(ws + WS_ZS); p.OS = (float*)(ws + WS_OS);
#if N_LAUNCHES == 1
    p.ph_lo = 0; p.ph_hi = 6;
    void* args[] = {&p};
    hipError_t e = hipLaunchCooperativeKernel((const void*)hymba_fwd, dim3(grid), dim3(512), args, LDS_BYTES, stream);
    if (e != hipSuccess) fprintf(stderr, "kernel_launch: cooperative launch failed: %s (grid %d)\n", hipGetErrorString(e), grid);
#else
    for (int ph = 0; ph < 6; ++ph) { p.ph_lo = ph; p.ph_hi = ph + 1; hipLaunchKernelGGL(hymba_fwd, dim3(grid), dim3(512), LDS_BYTES, stream, p); }
#endif
}
```

```cpp
#include <hip/hip_runtime.h>
#include <hip/hip_cooperative_groups.h>
#include <cstdio>
#include <cstdint>
namespace cg = cooperative_groups;
namespace pg8 {
#define PG8_LAS __attribute__((address_space(3)))
typedef unsigned short bf16_t;
typedef short bf16x8 __attribute__((ext_vector_type(8)));
typedef float f32x4 __attribute__((ext_vector_type(4)));
typedef unsigned u32x4 __attribute__((ext_vector_type(4)));
constexpr int BM = 256, BK = 64, HALF = 128, HTB = HALF * BK * 2  , STAGE_BYTES = 8 * HTB, NXCD = 8, WGM = 8;

__host__ __device__ __forceinline__ int lds_byte(int r, int c) { const int st = (r >> 4) * 2 + (c >> 5), rr = r & 15, cc = c & 31, ob = rr * 64 + cc * 2; return st * 1024 + (ob ^ (((ob >> 9) & 1) << 5)); }
__host__ __device__ __forceinline__ void stage_rc(int b, int& R, int& C) { const int st = b / 1024, sb = b % 1024, swz = sb ^ (((sb >> 9) & 1) << 5); R = (st >> 1) * 16 + swz / 64; C = (st & 1) * 32 + (swz % 64) / 2; }
__host__ __device__ __forceinline__ int perm32(int rho) { const int n = rho >> 4, i = rho & 15; return 8 * (i >> 2) + 4 * n + (i & 3); }

struct Unit { int pm, pn; };
struct Gemm { const bf16_t* A; const bf16_t* Bt; int M, N, K; };

struct StaticOrder {
    int nM, nN, nwg, G, c;
    __host__ __device__ void init(int M, int N, int G_, int c_) { nM = M / BM; nN = N / BM; nwg = nM * nN; G = G_; c = c_; }
    __host__ __device__ bool next(int i, Unit& u) const {
        const long L = (long)i * G + c; if (L >= nwg) return false;
        int wgid = (int)L; { const int q = nwg / NXCD, r = nwg % NXCD, xcd = wgid % NXCD, off = wgid / NXCD; wgid = (xcd < r ? xcd * (q + 1) : r * (q + 1) + (xcd - r) * q) + off; }
        const int nig = WGM * nN, gid = wgid / nig, fm = gid * WGM, gsz = (nM - fm) < WGM ? (nM - fm) : WGM;
        u.pm = fm + ((wgid % nig) % gsz); u.pn = (wgid % nig) / gsz; return true;
    }
    __device__ __forceinline__ void a_ready(const Unit&) const {}
    __device__ __forceinline__ void done(const Unit&) const {}
};

__device__ __forceinline__ unsigned cvt_pk_bf16(float lo, float hi) { unsigned r; asm volatile("v_cvt_pk_bf16_f32 %0, %1, %2" : "=v"(r) : "v"(lo), "v"(hi)); return r; }
typedef float f32x2 __attribute__((ext_vector_type(2)));
template <class Epi, class Sched, bool ALIGN_EPI = false, bool SP2 = false>
__device__ __forceinline__ void gemm_phase(PG8_LAS unsigned char* lds, const Gemm g, const Sched& S, const Epi& E) {
    const int tid = threadIdx.x, wid = __builtin_amdgcn_readfirstlane(tid >> 6), lane = tid & 63, wr = wid >> 2, wc = wid & 3, fr = lane & 15, fq = lane >> 4;
    const int K = g.K, nt = K / BK;
    unsigned voffA[2], voffB[2];
#pragma unroll
    for (int i = 0; i < 2; ++i) { int R, C; stage_rc(tid * 16 + i * 8192, R, C); const int Rb = Epi::PERM ? ((R & ~31) + perm32(R & 31)) : R;
        voffA[i] = (unsigned)(R * K + C) * 2u; voffB[i] = (unsigned)(Rb * K + C) * 2u; }
    const size_t kstep = (size_t)(BK * 2);
    const size_t hstep = (size_t)HALF * K * 2;
    const size_t tstep = 2 * hstep;
    const unsigned ldsw = (unsigned)wid * 1024u;
    const int aoff = lds_byte(wr * 64 + fr, fq * 8), boff = lds_byte(wc * 32 + fr, fq * 8);
#define PG8_SA(b, h) (((b) * 2 + (h)) * HTB)
#define PG8_SB(b, h) ((4 + (b) * 2 + (h)) * HTB)
#define PG8_STAGE(bufoff, gbase, voff) do { _Pragma("unroll") for (int _i = 0; _i < 2; ++_i) \
        __builtin_amdgcn_global_load_lds((const unsigned*)((const char*)(gbase) + (voff)[_i]), (PG8_LAS unsigned*)(lds + (bufoff) + ldsw + _i * 8192), 16, 0, 0); } while (0)
#define PG8_LDA(dst, b, h) do { _Pragma("unroll") for (int m = 0; m < 4; ++m) _Pragma("unroll") for (int k = 0; k < 2; ++k) dst[m][k] = *(const PG8_LAS bf16x8*)(lds + PG8_SA(b, h) + aoff + m * 2048 + k * 1024); } while (0)
#define PG8_LDB(dst, b, h) do { _Pragma("unroll") for (int n = 0; n < 2; ++n) _Pragma("unroll") for (int k = 0; k < 2; ++k) dst[n][k] = *(const PG8_LAS bf16x8*)(lds + PG8_SB(b, h) + boff + n * 2048 + k * 1024); } while (0)
#define PG8_MMA(ai, bj, At, Bt) do { __builtin_amdgcn_s_setprio(1); _Pragma("unroll") for (int m = 0; m < 4; ++m) _Pragma("unroll") for (int n = 0; n < 2; ++n) _Pragma("unroll") for (int k = 0; k < 2; ++k) \
        acc[ai][bj][m][n] = __builtin_amdgcn_mfma_f32_16x16x32_bf16(Bt[n][k], At[m][k], acc[ai][bj][m][n], 0, 0, 0); __builtin_amdgcn_s_setprio(0); } while (0)
#define PG8_WAIT_V(n) asm volatile("s_waitcnt vmcnt(" #n ")" ::: "memory")
#define PG8_WAIT_L(n) asm volatile("s_waitcnt lgkmcnt(" #n ")" ::: "memory")
#define PG8_BAR __builtin_amdgcn_s_barrier()
#define PG8_SCHED __builtin_amdgcn_sched_barrier(0)
    Unit cur, nxt; int ui = 0;
    if (!S.next(0, cur)) return;
    f32x4 acc[2][2][4][2];
#pragma unroll
    for (int a = 0; a < 2; ++a)
#pragma unroll
        for (int b = 0; b < 2; ++b)
#pragma unroll
            for (int m = 0; m < 4; ++m)
#pragma unroll
                for (int n = 0; n < 2; ++n) acc[a][b][m][n] = (f32x4){0.f, 0.f, 0.f, 0.f};
    bf16x8 At[4][2], B0[2][2], B1[2][2];
    const char* cA = (const char*)g.A + (size_t)cur.pm * tstep; const char* cB = (const char*)g.Bt + (size_t)cur.pn * tstep;
    S.a_ready(cur);
    if constexpr (SP2) {
        PG8_STAGE(PG8_SB(0, 0), cB, voffB); PG8_STAGE(PG8_SB(0, 1), cB + hstep, voffB); PG8_STAGE(PG8_SA(0, 0), cA, voffA); PG8_STAGE(PG8_SA(0, 1), cA + hstep, voffA);
        if (wr == 1) PG8_BAR;
        PG8_WAIT_V(2); PG8_BAR;
        PG8_STAGE(PG8_SB(1, 0), cB + kstep, voffB); PG8_STAGE(PG8_SA(1, 0), cA + kstep, voffA); PG8_STAGE(PG8_SB(1, 1), cB + hstep + kstep, voffB);
        PG8_WAIT_V(6); PG8_BAR;
    } else {
        PG8_STAGE(PG8_SB(0, 0), cB, voffB); PG8_STAGE(PG8_SA(0, 0), cA, voffA); PG8_STAGE(PG8_SB(0, 1), cB + hstep, voffB); PG8_STAGE(PG8_SA(0, 1), cA + hstep, voffA);
        if (wr == 1) PG8_BAR;
        PG8_WAIT_V(4); PG8_BAR;
        PG8_STAGE(PG8_SB(1, 0), cB + kstep, voffB); PG8_STAGE(PG8_SA(1, 0), cA + kstep, voffA); PG8_STAGE(PG8_SB(1, 1), cB + hstep + kstep, voffB);
        PG8_WAIT_V(6); PG8_BAR;
    }
    for (;;) {
        const bool has_next = S.next(ui + 1, nxt);
        const char* nA = has_next ? (const char*)g.A + (size_t)nxt.pm * tstep : cA; const char* nB = has_next ? (const char*)g.Bt + (size_t)nxt.pn * tstep : cB;
        for (int t = 0; t < nt; t += 2) {
            const bool last = (t == nt - 2);
            const char* a1 = cA + (size_t)(t + 1) * kstep;
            const char* a2 = last ? nA : cA + (size_t)(t + 2) * kstep; const char* b2 = last ? nB : cB + (size_t)(t + 2) * kstep;
            const char* a3 = a2 + kstep; const char* b3 = b2 + kstep;
            if (last && has_next) S.a_ready(nxt);
            if constexpr (SP2) {
            PG8_LDB(B0, 0, 0); PG8_LDB(B1, 0, 1); PG8_SCHED; PG8_LDA(At, 0, 0); PG8_STAGE(PG8_SA(1, 1), a1 + hstep, voffA);
            PG8_WAIT_V(8); PG8_WAIT_L(0); PG8_BAR; PG8_MMA(0, 0, At, B0); PG8_MMA(0, 1, At, B1); PG8_BAR; PG8_SCHED;
            PG8_LDA(At, 0, 1); PG8_STAGE(PG8_SB(0, 0), b2, voffB); PG8_STAGE(PG8_SB(0, 1), b2 + hstep, voffB); PG8_STAGE(PG8_SA(0, 0), a2, voffA);
            PG8_WAIT_V(8); PG8_WAIT_L(0); PG8_BAR; PG8_MMA(1, 0, At, B0); PG8_MMA(1, 1, At, B1); PG8_BAR; PG8_SCHED;
            PG8_LDB(B0, 1, 0); PG8_LDB(B1, 1, 1); PG8_SCHED; PG8_LDA(At, 1, 0); PG8_STAGE(PG8_SA(0, 1), a2 + hstep, voffA);
            PG8_WAIT_V(8); PG8_WAIT_L(0); PG8_BAR; PG8_MMA(0, 0, At, B0); PG8_MMA(0, 1, At, B1); PG8_BAR; PG8_SCHED;
            PG8_LDA(At, 1, 1); PG8_STAGE(PG8_SB(1, 0), b3, voffB); PG8_STAGE(PG8_SB(1, 1), b3 + hstep, voffB); PG8_STAGE(PG8_SA(1, 0), a3, voffA);
            PG8_WAIT_V(8); PG8_WAIT_L(0); PG8_BAR; PG8_MMA(1, 0, At, B0); PG8_MMA(1, 1, At, B1); PG8_BAR; PG8_SCHED;
            } else {
            PG8_LDB(B0, 0, 0); PG8_SCHED; PG8_LDA(At, 0, 0); PG8_STAGE(PG8_SA(1, 1), a1 + hstep, voffA);
            PG8_WAIT_L(8); PG8_BAR; PG8_WAIT_L(0); PG8_MMA(0, 0, At, B0); PG8_BAR; PG8_SCHED;
            PG8_LDB(B1, 0, 1); PG8_STAGE(PG8_SB(0, 0), b2, voffB);
            PG8_BAR; PG8_WAIT_L(0); PG8_MMA(0, 1, At, B1); PG8_BAR;
            PG8_LDA(At, 0, 1); PG8_STAGE(PG8_SA(0, 0), a2, voffA);
            PG8_BAR; PG8_WAIT_L(0); PG8_MMA(1, 0, At, B0); PG8_BAR; PG8_SCHED;
            PG8_STAGE(PG8_SB(0, 1), b2 + hstep, voffB);
            PG8_WAIT_V(6); PG8_BAR; PG8_MMA(1, 1, At, B1); PG8_BAR;
            PG8_LDB(B0, 1, 0); PG8_SCHED; PG8_LDA(At, 1, 0); PG8_STAGE(PG8_SA(0, 1), a2 + hstep, voffA);
            PG8_WAIT_L(8); PG8_BAR; PG8_WAIT_L(0); PG8_MMA(0, 0, At, B0); PG8_BAR; PG8_SCHED;
            PG8_LDB(B1, 1, 1); PG8_STAGE(PG8_SB(1, 0), b3, voffB);
            PG8_BAR; PG8_WAIT_L(0); PG8_MMA(0, 1, At, B1); PG8_BAR;
            PG8_LDA(At, 1, 1); PG8_STAGE(PG8_SA(1, 0), a3, voffA);
            PG8_BAR; PG8_WAIT_L(0); PG8_MMA(1, 0, At, B0); PG8_BAR; PG8_SCHED;
            PG8_STAGE(PG8_SB(1, 1), b3 + hstep, voffB);
            PG8_WAIT_V(6); PG8_BAR; PG8_MMA(1, 1, At, B1); PG8_BAR;
            }
        }
        if constexpr (ALIGN_EPI) { if (wr == 0) PG8_BAR; }
        if constexpr (!Epi::AFTER_DRAIN) { E(acc, cur, wr, wc, fr, fq); S.done(cur); }
        if (!has_next) break;
#pragma unroll
        for (int a = 0; a < 2; ++a)
#pragma unroll
            for (int b = 0; b < 2; ++b)
#pragma unroll
                for (int m = 0; m < 4; ++m)
#pragma unroll
                    for (int n = 0; n < 2; ++n) acc[a][b][m][n] = (f32x4){0.f, 0.f, 0.f, 0.f};
        cur = nxt; cA = nA; cB = nB; ++ui;
        if constexpr (ALIGN_EPI) { if (wr == 1) PG8_BAR; }
    }
    PG8_WAIT_V(0);
    if constexpr (!ALIGN_EPI) { if (wr == 0) PG8_BAR; }
    PG8_BAR;
    if constexpr (Epi::AFTER_DRAIN) { E.fused(acc, cur, wr, wc, fr, fq, lds, wid, lane); S.done(cur); }
#undef PG8_SA
#undef PG8_SB
#undef PG8_STAGE
#undef PG8_LDA
#undef PG8_LDB
#undef PG8_MMA
#undef PG8_WAIT_V
#undef PG8_WAIT_L
#undef PG8_BAR
#undef PG8_SCHED
}
}

using pg8::bf16_t; using pg8::bf16x8; using pg8::f32x4; using pg8::u32x4;
#define GAS __attribute__((address_space(1)))
#define LAS __attribute__((address_space(3)))
typedef unsigned v4u __attribute__((ext_vector_type(4)));
typedef unsigned u32x2 __attribute__((ext_vector_type(2)));
typedef float f32x16 __attribute__((ext_vector_type(16)));
typedef float f32x2_t __attribute__((ext_vector_type(2)));
typedef __bf16 bf16x2_t __attribute__((ext_vector_type(2)));
#define LDS_WAIT() asm volatile("s_waitcnt lgkmcnt(0)" ::: "memory")
__device__ __forceinline__ unsigned f2bf(float f) { unsigned u = __builtin_bit_cast(unsigned, f); return (u + 0x7fffu + ((u >> 16) & 1u)) >> 16; }
__device__ __forceinline__ unsigned pk2(float lo, float hi) { return f2bf(lo) | (f2bf(hi) << 16); }
__device__ __forceinline__ unsigned pkbf(float lo, float hi) { f32x2_t v = {lo, hi}; bf16x2_t b = __builtin_convertvector(v, bf16x2_t); return __builtin_bit_cast(unsigned, b); }
__device__ __forceinline__ float bflo(unsigned w) { return __uint_as_float(w << 16); }
__device__ __forceinline__ float bfhi(unsigned w) { return __uint_as_float(w & 0xffff0000u); }
__device__ __forceinline__ float wave_sum(float v) {
#pragma unroll
    for (int o = 1; o < 64; o <<= 1) v += __shfl_xor(v, o);
    return v;
}
__device__ __forceinline__ float wave_max(float v) {
#pragma unroll
    for (int o = 1; o < 64; o <<= 1) v = fmaxf(v, __shfl_xor(v, o));
    return v;
}
__device__ __forceinline__ float gelu_t(float x) {
    const float u = 0.7978845608028654f * (x + 0.044715f * x * x * x);
    return x * __builtin_amdgcn_rcpf(1.f + __expf(-2.f * u));
}
__device__ __forceinline__ float silu_f(float x) { return x * __builtin_amdgcn_rcpf(1.f + __expf(-x)); }

constexpr int DM = 1024, T = 16384, NB = 2, MP = NB * T, SBT = 8, STT = 16, MS = SBT * STT, DIN = 3584;
constexpr int SEG_U = 0, SEG_V = 512, SEG_G = 1024, SEG_Q = 1536, SEG_K = 2048, SEG_VV = 2560, SEG_GB = 3072;
constexpr float EPS = 1e-6f;
constexpr size_t OUT_YP = 0, OUT_YS = 33554432, OUT_KP = 33685504, OUT_VP = 34209792, OUT_KS = 34734080, OUT_VS = 34799616, OUT_GV = 34865152;
constexpr size_t MiB = 1u << 20;
constexpr size_t WS_MOD = 0, WS_QCTR = 512 * 1024, WS_PCNT = 640 * 1024, WS_BAR = 768 * 1024, WS_WIN = 1 * MiB, WS_WOUT = 8 * MiB, WS_WST = 10 * MiB, WS_STATS = 11 * MiB, WS_XN = 16 * MiB, WS_ZB = 96 * MiB,
                 WS_GVT = 320 * MiB, WS_VT = 352 * MiB, WS_OB = 384 * MiB, WS_ZS = 448 * MiB, WS_OS = 450 * MiB, WS_END = 451 * MiB;
constexpr int LDS_BYTES = 147456;
__device__ __forceinline__ size_t zb_off(int seg, int b, int hg, int t) { return ((((size_t)seg * 2 + b) * 8 + hg) * T + t) * 64; }

struct P {
    const float *x_prompt, *x_sample, *cache_k, *cache_v, *c_prompt, *c_sample, *g_pre, *w_ada, *b_ada, *w_in, *ln_g, *ln_b, *w_s, *b_s, *rel_bias, *w_out, *g_post;
    float* out;
    float* MOD; bf16_t* WIN; bf16_t* WOUT; bf16_t* WST; float* STATS; bf16_t* XN; bf16_t* ZB; bf16_t* GVT; bf16_t* VT; bf16_t* OB; float* ZS; float* OS; unsigned* QCTR; unsigned* PCNT; unsigned* BAR;
    int ph_lo, ph_hi;
};
__device__ __forceinline__ void p0_transpose_item(const float* W, int K, int N, bf16_t* WT, int row_off, LAS float* scr, int item, int lane) {
    const int nblk = N / 32, kb = item / nblk, nb = item % nblk, k0 = 64 * kb, n0 = 32 * nb;
#pragma unroll
    for (int i = 0; i < 32; ++i) { const int kk = 2 * i + (lane >> 5); scr[kk * 33 + (lane & 31)] = W[(size_t)(k0 + kk) * N + n0 + (lane & 31)]; }
    LDS_WAIT(); asm volatile("" ::: "memory");
    const int c = lane & 7;
#pragma unroll
    for (int j = 0; j < 4; ++j) { const int n = (lane >> 3) + 8 * j; const LAS float* s = scr + (8 * c) * 33 + n;
        v4u o; o.x = pk2(s[0 * 33], s[1 * 33]); o.y = pk2(s[2 * 33], s[3 * 33]); o.z = pk2(s[4 * 33], s[5 * 33]); o.w = pk2(s[6 * 33], s[7 * 33]);
        *(GAS v4u*)(WT + (size_t)(row_off + n0 + n) * K + k0 + 8 * c) = o; }
    LDS_WAIT(); asm volatile("" ::: "memory");
}
__device__ __forceinline__ void phase0(const P& p, LAS unsigned char* lds, int tid, int wave, int lane) {
    if (blockIdx.x < 192) {
        LAS float* sc = (LAS float*)lds;
        LAS float* red = sc + 10240;
        for (int i = tid; i < 10240; i += 512) { const int b = i >> 10, k = i & 1023; const float c = b < 2 ? p.c_prompt[b * 1024 + k] : p.c_sample[(b - 2) * 1024 + k]; sc[i] = silu_f(c); }
        __syncthreads();
        const int j0 = blockIdx.x * 16, j = lane & 15, ks = lane >> 4;
        float acc[10];
#pragma unroll
        for (int b = 0; b < 10; ++b) acc[b] = 0.f;
#pragma unroll
        for (int i = 0; i < 32; ++i) { const int k = wave * 128 + i * 4 + ks; const float w = p.w_ada[(size_t)k * 3072 + j0 + j];
#pragma unroll
            for (int b = 0; b < 10; ++b) acc[b] += sc[b * 1024 + k] * w; }
#pragma unroll
        for (int b = 0; b < 10; ++b) { acc[b] += __shfl_xor(acc[b], 16); acc[b] += __shfl_xor(acc[b], 32); }
        if (lane < 16) {
#pragma unroll
            for (int b = 0; b < 10; ++b) red[(wave * 10 + b) * 16 + j] = acc[b]; }
        __syncthreads();
        if (tid < 160) { const int b = tid >> 4, jj = tid & 15; float s = p.b_ada[j0 + jj];
#pragma unroll
            for (int w = 0; w < 8; ++w) s += red[(w * 10 + b) * 16 + jj];
            p.MOD[b * 3072 + j0 + jj] = s; }
        __syncthreads();
    }
}

__device__ __forceinline__ void phase0b(const P& p, LAS unsigned char* lds, int tid, int wave, int lane) {
    if (blockIdx.x == 0 && tid < 8) p.QCTR[64 * tid] = 0u;
    if (blockIdx.x == 1 && tid < 128) p.PCNT[64 * tid] = 0u;
    LAS float* scr = (LAS float*)(lds + wave * 16384);
    const int gw = blockIdx.x * 8 + wave, NGW = gridDim.x * 8;
    constexpr int I_IN = (DM / 64) * (DIN / 32), I_OUT = (DM / 64) * (DM / 32);
    for (int it = gw; it < I_IN + I_OUT; it += NGW) {
        if (it < I_IN) p0_transpose_item(p.w_in, DM, DIN, p.WIN, 0, scr, it, lane);
        else p0_transpose_item(p.w_out, DM, DM, p.WOUT, 0, scr, it - I_IN, lane);
    }
    for (int i = blockIdx.x * 512 + tid; i < 8 * 128 * 128; i += gridDim.x * 512) { const int t = (i >> 7) & 127, s = i & 127; p.WST[i] = (bf16_t)f2bf(s <= t ? p.w_s[i] : 0.f); }
}

__device__ __forceinline__ const float* p1_row(const P& p, int m) { return m < MP ? p.x_prompt + (size_t)m * DM : p.x_sample + (size_t)(m - MP) * DM; }
__device__ __forceinline__ void phase1(const P& p, int wave, int lane) {
    const int gw = blockIdx.x * 8 + wave, NGW = gridDim.x * 8, NR = MP + MS, RPW = (NR + NGW - 1) / NGW;
    const int m0 = gw * RPW, m1 = (m0 + RPW < NR) ? m0 + RPW : NR;
    constexpr int PD = 4;
    f32x4 v[4], nx[PD][4];
#pragma unroll
    for (int d = 0; d < PD; ++d) if (m0 + d < m1) { const f32x4* xr = (const f32x4*)p1_row(p, m0 + d) + lane;
#pragma unroll
        for (int j = 0; j < 4; ++j) nx[d][j] = xr[64 * j]; }
    f32x4 ga[4], sh[4]; int bcur = -1;
    for (int m = m0; m < m1; ++m) {
#pragma unroll
        for (int j = 0; j < 4; ++j) { v[j] = nx[0][j];
#pragma unroll
            for (int d = 0; d + 1 < PD; ++d) nx[d][j] = nx[d + 1][j]; }
        if (m + PD < m1) { const f32x4* xr = (const f32x4*)p1_row(p, m + PD) + lane;
#pragma unroll
            for (int j = 0; j < 4; ++j) nx[PD - 1][j] = xr[64 * j]; }
        const int b = m < MP ? (m >> 14) : 2 + ((m - MP) >> 4);
        if (b != bcur) { bcur = b; const float* mod = p.MOD + b * 3072;
#pragma unroll
            for (int j = 0; j < 4; ++j) { const int c = 4 * lane + 256 * j; ga[j] = *(const f32x4*)(p.g_pre + c) * (*(const f32x4*)(mod + 1024 + c) + 1.f); sh[j] = *(const f32x4*)(mod + c); } }
        float s = 0.f;
#pragma unroll
        for (int j = 0; j < 4; ++j) s += (v[j].x * v[j].x + v[j].y * v[j].y) + (v[j].z * v[j].z + v[j].w * v[j].w);
        const float rstd = rsqrtf(wave_sum(s) * (1.f / DM) + EPS);
        u32x2* o8 = (u32x2*)(p.XN + (size_t)m * DM) + lane;
#pragma unroll
        for (int j = 0; j < 4; ++j) { const f32x4 hh = v[j] * rstd * ga[j] + sh[j];
            u32x2 w; w.x = pkbf(hh.x, hh.y); w.y = pkbf(hh.z, hh.w); o8[64 * j] = w; }
    }
}

struct EpiIn {
    static constexpr bool PERM = true, AFTER_DRAIN = false;
    bf16_t* ZB; bf16_t* GVT; bf16_t* VT; float* STATS; float* outK; float* outV;
    __device__ __forceinline__ void operator()(const f32x4 (&acc)[2][2][4][2], const pg8::Unit& u, int wr, int wc, int fr, int fq) const {
        const int seg = u.pn >> 1, cs0 = (u.pn & 1) * 256 + wc * 32 + 8 * fq, row0 = u.pm * 256 + wr * 64 + fr;
        if (seg == 1 || seg == 5) {
#pragma unroll
            for (int ai = 0; ai < 2; ++ai)
#pragma unroll
                for (int m = 0; m < 4; ++m) { const int row = row0 + ai * 128 + m * 16, b = row >> 14, t = row & (T - 1);
                    float s1 = 0.f, s2 = 0.f;
#pragma unroll
                    for (int bj = 0; bj < 2; ++bj) { const int cs = cs0 + bj * 128; float v[8];
#pragma unroll
                        for (int i = 0; i < 4; ++i) { v[i] = acc[ai][bj][m][0][i]; v[4 + i] = acc[ai][bj][m][1][i]; }
                        if (seg == 1) {
#pragma unroll
                            for (int i = 0; i < 8; ++i) { v[i] = gelu_t(v[i]); s1 += v[i]; s2 += v[i] * v[i]; } }
                        else if (t >= T - 512) { float* o = outV + ((size_t)(b * 512 + t - (T - 512))) * 512 + cs;
                            *(f32x4*)o = (f32x4){v[0], v[1], v[2], v[3]}; *(f32x4*)(o + 4) = (f32x4){v[4], v[5], v[6], v[7]}; }
                        bf16_t* d = (seg == 1) ? GVT + (((size_t)(b * 128 + (t >> 7))) * 512 + cs) * 128 + (t & 127) : VT + ((((size_t)(b * 8 + (cs >> 6))) * 256 + (t >> 6)) * 64 + (cs & 63)) * 64 + (t & 63);
                        const int ds = (seg == 1) ? 128 : 64;
#pragma unroll
                        for (int i = 0; i < 4; ++i) { const unsigned w = pkbf(v[2 * i], v[2 * i + 1]); d[(2 * i) * ds] = (bf16_t)(w & 0xffffu); d[(2 * i + 1) * ds] = (bf16_t)(w >> 16); }
                    }
                    if (seg == 1) { s1 += __shfl_xor(s1, 16); s1 += __shfl_xor(s1, 32); s2 += __shfl_xor(s2, 16); s2 += __shfl_xor(s2, 32);
                        if (fq == 0) { f32x2_t sv = {s1, s2}; *(f32x2_t*)(STATS + (size_t)row * 16 + ((u.pn & 1) * 4 + wc) * 2) = sv; } }
                }
        } else {
#pragma unroll
            for (int ai = 0; ai < 2; ++ai)
#pragma unroll
                for (int m = 0; m < 4; ++m) { const int row = row0 + ai * 128 + m * 16, b = row >> 14, t = row & (T - 1);
#pragma unroll
                    for (int bj = 0; bj < 2; ++bj) { const int cs = cs0 + bj * 128; float v[8];
#pragma unroll
                        for (int i = 0; i < 4; ++i) { v[i] = acc[ai][bj][m][0][i]; v[4 + i] = acc[ai][bj][m][1][i]; }
                        if (seg == 0) {
#pragma unroll
                            for (int i = 0; i < 8; ++i) v[i] = gelu_t(v[i]); }
                        else if (seg == 2 || seg == 6) {
#pragma unroll
                            for (int i = 0; i < 8; ++i) v[i] = silu_f(v[i]); }
                        else if (seg == 3) {
#pragma unroll
                            for (int i = 0; i < 8; ++i) v[i] *= 0.125f; }
                        else if (t >= T - 512) { float* o = outK + ((size_t)(b * 512 + t - (T - 512))) * 512 + cs;
                            *(f32x4*)o = (f32x4){v[0], v[1], v[2], v[3]}; *(f32x4*)(o + 4) = (f32x4){v[4], v[5], v[6], v[7]}; }
                        u32x4 w; w.x = pkbf(v[0], v[1]); w.y = pkbf(v[2], v[3]); w.z = pkbf(v[4], v[5]); w.w = pkbf(v[6], v[7]);
                        *(u32x4*)(ZB + zb_off(seg, b, cs >> 6, t) + (cs & 63)) = w; }
                }
        }
    }
};
struct EpiOut {
    static constexpr bool PERM = true, AFTER_DRAIN = false;
    const float* x; float* y; const float* MOD; const float* g_post; float* slot; unsigned* cnt;
    __device__ __forceinline__ void operator()(const f32x4 (&acc)[2][2][4][2], const pg8::Unit& u, int wr, int wc, int fr, int fq) const {
        const int c0 = u.pn * 256 + wc * 32 + 8 * fq, row0 = u.pm * 256 + wr * 64 + fr;
        float ssq[2][4];
#pragma unroll
        for (int ai = 0; ai < 2; ++ai)
#pragma unroll
            for (int m = 0; m < 4; ++m) { float s = 0.f;
#pragma unroll
                for (int bj = 0; bj < 2; ++bj)
#pragma unroll
                    for (int n = 0; n < 2; ++n) { const f32x4 v = acc[ai][bj][m][n]; s += (v[0] * v[0] + v[1] * v[1]) + (v[2] * v[2] + v[3] * v[3]); }
                s += __shfl_xor(s, 16); s += __shfl_xor(s, 32); ssq[ai][m] = s; }
        if (fq == 0) {
#pragma unroll
            for (int ai = 0; ai < 2; ++ai)
#pragma unroll
                for (int m = 0; m < 4; ++m) __hip_atomic_store(slot + (size_t)(row0 + ai * 128 + m * 16) * 16 + u.pn * 4 + wc, ssq[ai][m], __ATOMIC_RELAXED, __HIP_MEMORY_SCOPE_AGENT); }
        asm volatile("s_waitcnt vmcnt(0)" ::: "memory");
        unsigned* pc = cnt + 64 * u.pm;
        if (fq == 0 && fr == 0) __hip_atomic_fetch_add(pc, 1u, __ATOMIC_RELAXED, __HIP_MEMORY_SCOPE_AGENT);
        const float* gate = MOD + (u.pm >> 6) * 3072 + 2048;
        f32x4 gg[2][2];
#pragma unroll
        for (int bj = 0; bj < 2; ++bj)
#pragma unroll
            for (int n = 0; n < 2; ++n) gg[bj][n] = *(const f32x4*)(gate + c0 + bj * 128 + 4 * n) * *(const f32x4*)(g_post + c0 + bj * 128 + 4 * n);
        const unsigned voff = (unsigned)((wr * 64 + fr) * DM + c0) * 4u;
        const char* xb = (const char*)(x + (size_t)(u.pm * 256) * DM); char* yb = (char*)(y + (size_t)(u.pm * 256) * DM);
        f32x4 xa[3][2][2];
#pragma unroll
        for (int k = 0; k < 3; ++k)
#pragma unroll
            for (int bj = 0; bj < 2; ++bj)
#pragma unroll
                for (int n = 0; n < 2; ++n) xa[k][bj][n] = *(const f32x4*)(xb + (size_t)(k * 16) * DM * 4 + voff + (bj * 128 + 4 * n) * 4);
        { unsigned spins = 0;
          while ((unsigned)__builtin_amdgcn_readfirstlane((int)__hip_atomic_load(pc, __ATOMIC_RELAXED, __HIP_MEMORY_SCOPE_AGENT)) < 32u) { __builtin_amdgcn_s_sleep(2); if (++spins > (1u << 24)) break; } }
        asm volatile("" ::: "memory");
        float rstd[2][4];
#pragma unroll
        for (int ai = 0; ai < 2; ++ai)
#pragma unroll
            for (int m = 0; m < 4; ++m) { const unsigned long long* sp = (const unsigned long long*)((const char*)(slot + (size_t)(u.pm * 256 + ai * 128 + m * 16) * 16) + (unsigned)((wr * 64 + fr) * 16 + 4 * fq) * 4u);
                const unsigned long long w0 = __hip_atomic_load(sp, __ATOMIC_RELAXED, __HIP_MEMORY_SCOPE_AGENT), w1 = __hip_atomic_load(sp + 1, __ATOMIC_RELAXED, __HIP_MEMORY_SCOPE_AGENT);
                float t = (__uint_as_float((unsigned)w0) + __uint_as_float((unsigned)(w0 >> 32))) + (__uint_as_float((unsigned)w1) + __uint_as_float((unsigned)(w1 >> 32)));
                rstd[ai][m] = t; }
#pragma unroll
        for (int ai = 0; ai < 2; ++ai)
#pragma unroll
            for (int m = 0; m < 4; ++m) { float t = rstd[ai][m]; t += __shfl_xor(t, 16); t += __shfl_xor(t, 32); rstd[ai][m] = rsqrtf(t * (1.f / DM) + EPS); }
#pragma unroll
        for (int k = 0; k < 8; ++k) { const int ai = k >> 2, m = k & 3;
#pragma unroll
            for (int bj = 0; bj < 2; ++bj)
#pragma unroll
                for (int n = 0; n < 2; ++n) *(f32x4*)(yb + (size_t)(ai * 128 + m * 16) * DM * 4 + voff + (bj * 128 + 4 * n) * 4) = xa[k % 3][bj][n] + gg[bj][n] * (acc[ai][bj][m][n] * rstd[ai][m]);
            if (k + 3 < 8) { const int k2 = k + 3, ai2 = k2 >> 2, m2 = k2 & 3;
#pragma unroll
                for (int bj = 0; bj < 2; ++bj)
#pragma unroll
                    for (int n = 0; n < 2; ++n) xa[k % 3][bj][n] = *(const f32x4*)(xb + (size_t)(ai2 * 128 + m2 * 16) * DM * 4 + voff + (bj * 128 + 4 * n) * 4); }
        }
    }
};

__device__ __forceinline__ f32x4 small_gemm(const bf16_t* A, const bf16_t* Bt, int n0, int wave, int lane) {
    const int fr = lane & 15, fq = lane >> 4;
    const bf16x8* ap = (const bf16x8*)(A + (size_t)(wave * 16 + fr) * DM + 8 * fq);
    const bf16x8* bp = (const bf16x8*)(Bt + (size_t)(n0 + fr) * DM + 8 * fq);
    f32x4 acc = {0.f, 0.f, 0.f, 0.f};
#pragma unroll 16
    for (int ks = 0; ks < 32; ++ks) acc = __builtin_amdgcn_mfma_f32_16x16x32_bf16(bp[ks * 4], ap[ks * 4], acc, 0, 0, 0);
    return acc;
}
#ifdef TPROBE
__device__ unsigned long long tp_last, tp_acc;
#define TP_T0() do { asm volatile("s_waitcnt lgkmcnt(0)" ::: "memory"); tp_t = wall_clock64(); } while (0)
#define TP_MARK(k) do { asm volatile("s_waitcnt lgkmcnt(0)" ::: "memory"); __builtin_amdgcn_sched_barrier(0); const unsigned long long n_ = wall_clock64(); if (TPROBE == (k)) tp_sum += n_ - tp_t; tp_t = n_; } while (0)
#else
#define TP_T0() do {} while (0)
#define TP_MARK(k) do {} while (0)
#endif
#define MFMA32(a, b, c) __builtin_amdgcn_mfma_f32_32x32x16_bf16((a), (b), (c), 0, 0, 0)
__device__ __forceinline__ void attn_unit(const P& p, int b, int h, int ci, const LAS float* biasL, LAS unsigned char* wl, int lane, unsigned long long& tp_sum) {
    unsigned long long tp_t = 0; (void)tp_t;
    constexpr float LOG2E = 1.4426950408889634f;
    const int r = lane & 31, h2 = lane >> 5;
    const size_t rowbase = (size_t)b * T;
    bf16x8 qf[2][4];
#pragma unroll
    for (int qt = 0; qt < 2; ++qt)
#pragma unroll
        for (int ks = 0; ks < 4; ++ks) qf[qt][ks] = *(const bf16x8*)(p.ZB + zb_off(3, b, h, ci * 64 + qt * 32 + r) + 16 * ks + 8 * h2);
    f32x16 o[2][2];
#pragma unroll
    for (int dt = 0; dt < 2; ++dt)
#pragma unroll
        for (int qt = 0; qt < 2; ++qt)
#pragma unroll
            for (int i = 0; i < 16; ++i) o[dt][qt][i] = 0.f;
    float m_used[2] = {-1e30f, -1e30f}, lsum[2] = {0.f, 0.f};
    const int cj0 = ci > 8 ? ci - 8 : 0, nblk = (ci - cj0 + 1) * 2, key_start = cj0 * 64;
    const int krow = lane >> 3, kch = lane & 7, vrow = lane >> 2, vch = lane & 3;
    const char* kg = (const char*)(p.ZB + zb_off(4, b, h, key_start));
    const char* vg = (const char*)(p.VT + (((size_t)(b * 8 + h)) * 256 + cj0) * 4096);
    const unsigned koff = (unsigned)(krow * 64 + 8 * kch) * 2u, voff = (unsigned)(vrow * 64 + 8 * vch) * 2u;
    LAS unsigned char* Ks = wl; LAS unsigned char* Vs = wl + 4608;
    LAS unsigned char* kw = Ks + krow * 144 + kch * 16; LAS unsigned char* vw = Vs + vrow * 72 + vch * 16;
    const LAS unsigned char* kr = Ks + r * 144 + h2 * 16; const LAS unsigned char* vr = Vs + r * 72 + h2 * 8;
    u32x4 sk[4], sv[4];
#pragma unroll
    for (int i = 0; i < 4; ++i) { sk[i] = *(const u32x4*)(kg + i * 1024 + koff); sv[i] = *(const u32x4*)(vg + i * 2048 + voff); }
    for (int blk = 0; blk < nblk; ++blk) {
        TP_T0();
        const int key0 = key_start + blk * 32;
#pragma unroll
        for (int i = 0; i < 4; ++i) { *(LAS u32x4*)(kw + i * 8 * 144) = sk[i];
            u32x2 lo = {sv[i].x, sv[i].y}, hi = {sv[i].z, sv[i].w}; *(LAS u32x2*)(vw + i * 16 * 72) = lo; *(LAS u32x2*)(vw + i * 16 * 72 + 8) = hi; }
        { const int nb = blk + 1 < nblk ? blk + 1 : blk;
#pragma unroll
          for (int i = 0; i < 4; ++i) { sk[i] = *(const u32x4*)(kg + (size_t)nb * 4096 + i * 1024 + koff); sv[i] = *(const u32x4*)(vg + (size_t)(nb >> 1) * 8192 + (nb & 1) * 64 + i * 2048 + voff); } }
        bf16x8 kf[4];
#pragma unroll
        for (int ks = 0; ks < 4; ++ks) kf[ks] = *(const LAS bf16x8*)(kr + ks * 32);
        TP_MARK(1);
        const bool far = key0 + 31 + 128 <= ci * 64;
        const float bcst = far ? biasL[256] : 0.f;
#pragma unroll
        for (int qt = 0; qt < 2; ++qt) {
            bf16x8 pf[2];
            f32x16 s;
#pragma unroll
            for (int i = 0; i < 16; ++i) s[i] = 0.f;
#pragma unroll
            for (int ks = 0; ks < 4; ++ks) s = MFMA32(kf[ks], qf[qt][ks], s);
            if (!far) {
#pragma unroll
                for (int i = 0; i < 16; ++i) { const int key = key0 + (i & 3) + 8 * (i >> 2) + 4 * h2; int dist = ci * 64 + qt * 32 + r - key; dist = dist < -128 ? -128 : (dist > 128 ? 128 : dist); s[i] += biasL[dist + 128]; }
            }
            float a = fmaxf(s[0], s[1]);
#pragma unroll
            for (int i = 2; i < 16; i += 2) a = fmaxf(a, fmaxf(s[i], s[i + 1]));
            const float mx = fmaxf(a, __shfl_xor(a, 32)) + bcst;
            if (__builtin_amdgcn_ballot_w64(mx > m_used[qt] + 8.f) != 0ull) {
                const float mnew = fmaxf(m_used[qt], mx), alpha = __builtin_amdgcn_exp2f((m_used[qt] - mnew) * LOG2E); lsum[qt] *= alpha; m_used[qt] = mnew;
#pragma unroll
                for (int dt = 0; dt < 2; ++dt)
#pragma unroll
                    for (int i = 0; i < 16; ++i) o[dt][qt][i] *= alpha;
            }
            const float cb = (bcst - m_used[qt]) * LOG2E;
#pragma unroll
            for (int i = 0; i < 16; ++i) { const float e = __builtin_amdgcn_exp2f(s[i] * LOG2E + cb); s[i] = e; lsum[qt] += e; }
#pragma unroll
            for (int sp = 0; sp < 2; ++sp) { u32x4 w; w.x = pkbf(s[8 * sp], s[8 * sp + 1]); w.y = pkbf(s[8 * sp + 2], s[8 * sp + 3]); w.z = pkbf(s[8 * sp + 4], s[8 * sp + 5]); w.w = pkbf(s[8 * sp + 6], s[8 * sp + 7]);
                pf[sp] = __builtin_bit_cast(bf16x8, w); }
            if (qt == 0) TP_MARK(2);
#pragma unroll
            for (int dt = 0; dt < 2; ++dt)
#pragma unroll
                for (int sp = 0; sp < 2; ++sp) { const u32x2 v0 = *(const LAS u32x2*)(vr + dt * 32 * 72 + sp * 32), v1 = *(const LAS u32x2*)(vr + dt * 32 * 72 + sp * 32 + 16);
                    u32x4 w; w.x = v0.x; w.y = v0.y; w.z = v1.x; w.w = v1.y; const bf16x8 vf = __builtin_bit_cast(bf16x8, w);
                    o[dt][qt] = MFMA32(vf, pf[sp], o[dt][qt]); }
        }
        TP_MARK(3);
    }
#pragma unroll
    for (int qt = 0; qt < 2; ++qt) { const float l = lsum[qt] + __shfl_xor(lsum[qt], 32), inv = 1.f / l;
#pragma unroll
        for (int dt = 0; dt < 2; ++dt)
#pragma unroll
            for (int g4 = 0; g4 < 4; ++g4) { const f32x4 v = {o[dt][qt][4 * g4] * inv, o[dt][qt][4 * g4 + 1] * inv, o[dt][qt][4 * g4 + 2] * inv, o[dt][qt][4 * g4 + 3] * inv};
                *(LAS f32x4*)(wl + r * 272 + (32 * dt + 8 * g4 + 4 * h2) * 4) = v; }
        const int er = lane >> 4, ec = (lane & 15) * 4;
#pragma unroll
        for (int i = 0; i < 8; ++i) { const int q = er + 4 * i; const f32x4 v = *(const LAS f32x4*)(wl + q * 272 + ec * 4); const size_t row = rowbase + ci * 64 + qt * 32 + q;
            const u32x2 gb = *(const u32x2*)(p.ZB + zb_off(6, b, h, ci * 64 + qt * 32 + q) + ec);
            u32x2 w; w.x = pkbf(v.x * bflo(gb.x), v.y * bfhi(gb.x)); w.y = pkbf(v.z * bflo(gb.y), v.w * bfhi(gb.y));
            *(u32x2*)(p.XN + row * DM + 512 + h * 64 + ec) = w; }
    }
}

__device__ __forceinline__ void gmlp_unit(const P& p, int b, int n, int g, LAS float* scr, int lane) {
    const int r = lane & 31, h2 = lane >> 5;
    const size_t rowbase = (size_t)b * T + n * 128;
    const bf16_t* abase = p.GVT + (((size_t)(b * 128 + n)) * 512 + g * 64 + r) * 128 + 8 * h2;
    const bf16_t* wbase = p.WST + ((size_t)(g * 128 + r)) * 128 + 8 * h2;
    f32x4 sa[2][4]; u32x4 raw[2][8]; bf16x8 wf[8];
#pragma unroll
    for (int e = 0; e < 2; ++e) { const f32x4* sp = (const f32x4*)(p.STATS + (rowbase + lane + 64 * e) * 16);
#pragma unroll
        for (int i = 0; i < 4; ++i) sa[e][i] = sp[i]; }
#pragma unroll
    for (int dt = 0; dt < 2; ++dt)
#pragma unroll
        for (int ks = 0; ks < 8; ++ks) raw[dt][ks] = *(const u32x4*)(abase + dt * 32 * 128 + 16 * ks);
#pragma unroll
    for (int ks = 0; ks < 2; ++ks) wf[ks] = *(const bf16x8*)(wbase + 16 * ks);
    float lg[2], lb[2];
#pragma unroll
    for (int dt = 0; dt < 2; ++dt) { lg[dt] = p.ln_g[g * 64 + 32 * dt + r]; lb[dt] = p.ln_b[g * 64 + 32 * dt + r]; }
#pragma unroll
    for (int e = 0; e < 2; ++e) { const int tl = lane + 64 * e; const f32x4 a0 = sa[e][0], a1 = sa[e][1], a2 = sa[e][2], a3 = sa[e][3];
        const float s1 = ((a0.x + a0.z) + (a1.x + a1.z)) + ((a2.x + a2.z) + (a3.x + a3.z)), s2 = ((a0.y + a0.w) + (a1.y + a1.w)) + ((a2.y + a2.w) + (a3.y + a3.w));
        const float mean = s1 * (1.f / 512.f), var = fmaxf(s2 * (1.f / 512.f) - mean * mean, 0.f), rstd = rsqrtf(var + EPS);
        f32x2_t sv = {rstd, -mean * rstd}; *(LAS f32x2_t*)(scr + tl * 2) = sv; }
    bf16x8 af[2][8];
#pragma unroll
    for (int ks = 0; ks < 8; ++ks) {
        f32x4 st[4];
#pragma unroll
        for (int i = 0; i < 4; ++i) st[i] = *(const LAS f32x4*)(scr + (16 * ks + 8 * h2) * 2 + 4 * i);
#pragma unroll
        for (int dt = 0; dt < 2; ++dt) { u32x4 w;
#pragma unroll
            for (int i = 0; i < 4; ++i) { const float x0 = bflo(raw[dt][ks][i]), x1 = bfhi(raw[dt][ks][i]);
                const float y0 = x0 * (st[i].x * lg[dt]) + (st[i].y * lg[dt] + lb[dt]), y1 = x1 * (st[i].z * lg[dt]) + (st[i].w * lg[dt] + lb[dt]); w[i] = pkbf(y0, y1); }
            af[dt][ks] = __builtin_bit_cast(bf16x8, w); }
    }
    LAS unsigned char* wl = (LAS unsigned char*)scr;
    const int er = lane >> 4, ec = (lane & 15) * 4;
#pragma unroll
    for (int tt = 0; tt < 4; ++tt) {
        bf16x8 wn[8];
        if (tt < 3) {
#pragma unroll
            for (int ks = 0; ks < 2 * tt + 4; ++ks) wn[ks] = *(const bf16x8*)(wbase + (size_t)((tt + 1) * 32) * 128 + 16 * ks); }
        u32x2 uu[8], sg[8];
#pragma unroll
        for (int i = 0; i < 8; ++i) { const int t = n * 128 + 32 * tt + er + 4 * i; uu[i] = *(const u32x2*)(p.ZB + zb_off(0, b, g, t) + ec); sg[i] = *(const u32x2*)(p.ZB + zb_off(2, b, g, t) + ec); }
        const float bs = p.b_s[g * 128 + 32 * tt + r];
        f32x16 acc[2];
#pragma unroll
        for (int dt = 0; dt < 2; ++dt)
#pragma unroll
            for (int i = 0; i < 16; ++i) acc[dt][i] = 0.f;
#pragma unroll
        for (int ks = 0; ks < 2 * tt + 2; ++ks)
#pragma unroll
            for (int dt = 0; dt < 2; ++dt) acc[dt] = MFMA32(af[dt][ks], wf[ks], acc[dt]);
#pragma unroll
        for (int dt = 0; dt < 2; ++dt)
#pragma unroll
            for (int g4 = 0; g4 < 4; ++g4) { const f32x4 v = {acc[dt][4 * g4] + bs, acc[dt][4 * g4 + 1] + bs, acc[dt][4 * g4 + 2] + bs, acc[dt][4 * g4 + 3] + bs};
                *(LAS f32x4*)(wl + r * 272 + (32 * dt + 8 * g4 + 4 * h2) * 4) = v; }
#pragma unroll
        for (int i = 0; i < 8; ++i) { const int tl = er + 4 * i; const f32x4 v = *(const LAS f32x4*)(wl + tl * 272 + ec * 4); const size_t row = rowbase + 32 * tt + tl;
            u32x2 w; w.x = pkbf(bflo(uu[i].x) * v.x * bflo(sg[i].x), bfhi(uu[i].x) * v.y * bfhi(sg[i].x)); w.y = pkbf(bflo(uu[i].y) * v.z * bflo(sg[i].y), bfhi(uu[i].y) * v.w * bfhi(sg[i].y));
            *(u32x2*)(p.XN + row * DM + g * 64 + ec) = w; }
        if (tt < 3) {
#pragma unroll
            for (int ks = 0; ks < 2 * tt + 4; ++ks) wf[ks] = wn[ks]; }
    }
}

__device__ __forceinline__ void sgmlp_unit(const P& p, int b, int g, int lane) {
    const int c = g * 64 + lane; const float lgc = p.ln_g[c], lbc = p.ln_b[c];
    float vn[16];
#pragma unroll
    for (int s = 0; s < 16; ++s) { const int row = b * 16 + s; const float* zr = p.ZS + (size_t)row * DIN + SEG_V;
        const f32x4 a = *(const f32x4*)(zr + 4 * lane), bq = *(const f32x4*)(zr + 256 + 4 * lane);
        const float mean = wave_sum((a.x + a.y) + (a.z + a.w) + (bq.x + bq.y) + (bq.z + bq.w)) * (1.f / 512.f);
        const f32x4 da = a - mean, db = bq - mean;
        const float var = wave_sum((da.x * da.x + da.y * da.y) + (da.z * da.z + da.w * da.w) + (db.x * db.x + db.y * db.y) + (db.z * db.z + db.w * db.w)) * (1.f / 512.f);
        vn[s] = (zr[c] - mean) * rsqrtf(var + EPS) * lgc + lbc;
        p.out[OUT_GV + (size_t)row * 512 + c] = vn[s]; }
#pragma unroll
    for (int t = 0; t < 16; ++t) { float acc = 0.f;
#pragma unroll
        for (int s = 0; s <= t; ++s) acc += p.w_s[(size_t)g * 16384 + t * 128 + s] * vn[s];
        const int row = b * 16 + t; const float* zr = p.ZS + (size_t)row * DIN;
        const float y = zr[SEG_U + c] * (acc + p.b_s[g * 128 + t]) * zr[SEG_G + c];
        p.XN[(size_t)(MP + row) * DM + c] = (bf16_t)f2bf(y); }
}
__device__ __forceinline__ void sattn_block(const P& p, int b, int t, LAS float* part, const LAS float* biasL, int wave, int lane) {
    const int head = lane >> 3, sub = lane & 7, row = b * 16 + t, hoff = head * 64 + 8 * sub;
    const float* zq = p.ZS + (size_t)row * DIN + SEG_Q + hoff;
    const f32x4 q0 = *(const f32x4*)zq, q1 = *(const f32x4*)(zq + 4);
    float m = -1e30f, l = 0.f; f32x4 a0 = {0.f, 0.f, 0.f, 0.f}, a1 = {0.f, 0.f, 0.f, 0.f};
    const LAS float* bh = biasL + head * 257;
    const float* kc = p.cache_k + ((size_t)(b * 512 + wave * 64)) * 512 + hoff; const float* vc = p.cache_v + ((size_t)(b * 512 + wave * 64)) * 512 + hoff;
    asm volatile("; SATTN_LOOP_BEGIN");
#pragma unroll 1
    for (int bt = 0; bt < 8; ++bt) {
        f32x4 k0[8], k1[8], v0[8], v1[8]; float s[8];
#pragma unroll
        for (int j = 0; j < 8; ++j) { const size_t o = (size_t)(bt * 8 + j) * 512; k0[j] = *(const f32x4*)(kc + o); k1[j] = *(const f32x4*)(kc + o + 4); v0[j] = *(const f32x4*)(vc + o); v1[j] = *(const f32x4*)(vc + o + 4); }
        float mx = -1e30f;
#pragma unroll
        for (int j = 0; j < 8; ++j) { const int kk = wave * 64 + bt * 8 + j;
            float a = ((q0.x * k0[j].x + q0.y * k0[j].y) + (q0.z * k0[j].z + q0.w * k0[j].w)) + ((q1.x * k1[j].x + q1.y * k1[j].y) + (q1.z * k1[j].z + q1.w * k1[j].w));
            a += __shfl_xor(a, 1); a += __shfl_xor(a, 2); a += __shfl_xor(a, 4);
            int dist = 512 + t - kk; dist = dist > 128 ? 128 : dist;
            s[j] = a + bh[dist + 128]; mx = fmaxf(mx, s[j]); }
        const float mnew = fmaxf(m, mx), alpha = __expf(m - mnew);
        l *= alpha; a0 = a0 * alpha; a1 = a1 * alpha; m = mnew;
#pragma unroll
        for (int j = 0; j < 8; ++j) { const float e = __expf(s[j] - m); l += e; a0 += v0[j] * e; a1 += v1[j] * e; }
    }
    asm volatile("; SATTN_LOOP_END");
    { f32x4 k0[2], k1[2], v0[2], v1[2]; float s[2];
#pragma unroll
        for (int j = 0; j < 2; ++j) { const float* zr = p.ZS + (size_t)(b * 16 + 2 * wave + j) * DIN + hoff; k0[j] = *(const f32x4*)(zr + SEG_K); k1[j] = *(const f32x4*)(zr + SEG_K + 4); v0[j] = *(const f32x4*)(zr + SEG_VV); v1[j] = *(const f32x4*)(zr + SEG_VV + 4); }
#pragma unroll
        for (int j = 0; j < 2; ++j) {
            float a = ((q0.x * k0[j].x + q0.y * k0[j].y) + (q0.z * k0[j].z + q0.w * k0[j].w)) + ((q1.x * k1[j].x + q1.y * k1[j].y) + (q1.z * k1[j].z + q1.w * k1[j].w));
            a += __shfl_xor(a, 1); a += __shfl_xor(a, 2); a += __shfl_xor(a, 4);
            s[j] = a + bh[t - (2 * wave + j) + 128]; }
        const float mnew = fmaxf(m, fmaxf(s[0], s[1])), alpha = __expf(m - mnew);
        l *= alpha; a0 = a0 * alpha; a1 = a1 * alpha; m = mnew;
#pragma unroll
        for (int j = 0; j < 2; ++j) { const float e = __expf(s[j] - m); l += e; a0 += v0[j] * e; a1 += v1[j] * e; }
    }
    LAS float* pp = part + (wave * 64 + lane) * 12;
    pp[0] = m; pp[1] = l; *(LAS f32x4*)(pp + 4) = a0; *(LAS f32x4*)(pp + 8) = a1;
    __syncthreads();
    if (wave == 0) { float M = -1e30f;
#pragma unroll
        for (int w = 0; w < 8; ++w) M = fmaxf(M, part[(w * 64 + lane) * 12]);
        float L = 0.f; f32x4 o0 = {0.f, 0.f, 0.f, 0.f}, o1 = {0.f, 0.f, 0.f, 0.f};
#pragma unroll
        for (int w = 0; w < 8; ++w) { const LAS float* q = part + (w * 64 + lane) * 12; const float f = __expf(q[0] - M); L += q[1] * f; o0 += *(const LAS f32x4*)(q + 4) * f; o1 += *(const LAS f32x4*)(q + 8) * f; }
        const float inv = 1.f / L; const float* gp = p.ZS + (size_t)row * DIN + SEG_GB + hoff; const f32x4 g0 = *(const f32x4*)gp, g1 = *(const f32x4*)(gp + 4);
        u32x4 w; w.x = pkbf(o0.x * inv * g0.x, o0.y * inv * g0.y); w.y = pkbf(o0.z * inv * g0.z, o0.w * inv * g0.w); w.z = pkbf(o1.x * inv * g1.x, o1.y * inv * g1.y); w.w = pkbf(o1.z * inv * g1.z, o1.w * inv * g1.w);
        *(u32x4*)(p.XN + (size_t)(MP + row) * DM + 512 + hoff) = w; }
    __syncthreads();
}

__device__ __forceinline__ void phase5(const P& p, int wave, int lane) {
    const int gw = blockIdx.x * 8 + wave, NGW = gridDim.x * 8;
    for (int ms = gw; ms < MS; ms += NGW) {
        const int b = 2 + (ms >> 4); const float* xrow = p.x_sample + (size_t)ms * DM; float* yrow = p.out + OUT_YS + (size_t)ms * DM;
        f32x4 ov[4]; float ss = 0.f;
#pragma unroll
        for (int j = 0; j < 2; ++j)
#pragma unroll
            for (int i = 0; i < 2; ++i) { ov[2 * j + i] = *(const f32x4*)(p.OS + (size_t)ms * DM + 8 * lane + 512 * j + 4 * i); const f32x4 w = ov[2 * j + i]; ss += (w.x * w.x + w.y * w.y) + (w.z * w.z + w.w * w.w); }
        const float rstd = rsqrtf(wave_sum(ss) * (1.f / DM) + EPS);
        const float* gate = p.MOD + b * 3072 + 2048;
#pragma unroll
        for (int j = 0; j < 2; ++j)
#pragma unroll
            for (int i = 0; i < 2; ++i) { const int c = 8 * lane + 512 * j + 4 * i;
                const f32x4 xv = *(const f32x4*)(xrow + c), gt = *(const f32x4*)(gate + c), gp = *(const f32x4*)(p.g_post + c);
                *(f32x4*)(yrow + c) = xv + gt * (ov[2 * j + i] * rstd * gp); }
    }
}
#define XB_TMO      128
#define XB_XCNT(j)  (256  + 64 * (j))
#define XB_XSUB(j)  (1280 + 64 * (j))
#define XB_XGEN(j)  (2304 + 64 * (j))
#define XB_TOP      3328
#define XB_TOPGEN   3392
#define XCD_BAR_WORDS 3456
#define XB_SPIN_CAP (1u << 18)

__device__ __forceinline__ unsigned xb_ld(unsigned* p)              { return __hip_atomic_load(p, __ATOMIC_RELAXED, __HIP_MEMORY_SCOPE_AGENT); }
__device__ __forceinline__ unsigned xb_add(unsigned* p, unsigned v) { return __hip_atomic_fetch_add(p, v, __ATOMIC_RELAXED, __HIP_MEMORY_SCOPE_AGENT); }
__device__ __forceinline__ unsigned xb_xcc_id() { return (unsigned)__builtin_amdgcn_s_getreg((3 << 11) | 20) & 0xFu; }
#define XB_SPIN(cond, bar) do { unsigned _sp = 0; while (cond) { __builtin_amdgcn_s_sleep(1); \
    if ((++_sp & 255u) == 0u) { if (xb_ld(&(bar)[XB_TMO])) break; if (_sp > XB_SPIN_CAP) { atomicAdd(&(bar)[XB_TMO], 1u); break; } } } } while (0)

struct XcdBarrier {
    unsigned* bar; unsigned x;
    volatile LAS unsigned* st;
};

__device__ __forceinline__ XcdBarrier xcd_barrier_post(unsigned* bar, volatile LAS unsigned* st) {
    XcdBarrier b; b.bar = bar; b.x = xb_xcc_id(); b.st = st;
    if (threadIdx.x == 0) (void)xb_add(&bar[XB_XCNT(b.x)], 1u);
    return b;
}
__device__ __forceinline__ void xcd_barrier_complete(unsigned* bar, unsigned x, unsigned& nloc, unsigned& nx) {
    const unsigned G = gridDim.x * gridDim.y * gridDim.z;
    unsigned sum, cnt, mine, sp = 0u;
    for (;;) {
        sum = 0u; cnt = 0u; mine = 0u;
#pragma unroll
        for (unsigned j = 0; j < 16; ++j) { const unsigned c = xb_ld(&bar[XB_XCNT(j)]); sum += c; cnt += (c > 0u) ? 1u : 0u; mine = (j == x) ? c : mine; }
        if (sum == G) break;
        __builtin_amdgcn_s_sleep(1);
        if ((++sp & 255u) == 0u) { if (xb_ld(&bar[XB_TMO])) break; if (sp > XB_SPIN_CAP) { atomicAdd(&bar[XB_TMO], 1u); break; } }
    }
    nloc = mine > 0u ? mine : 1u; nx = cnt > 0u ? cnt : 1u;
}

__device__ __forceinline__ void xcd_barrier(const XcdBarrier& b) {
    asm volatile("s_waitcnt vmcnt(0)" ::: "memory");
    __syncthreads();
    if (threadIdx.x == 0) {
        unsigned* bar = b.bar;
        __builtin_amdgcn_s_waitcnt(0);
        unsigned nloc = b.st[0], nx = b.st[1];
        if (nloc == 0u) { xcd_barrier_complete(bar, b.x, nloc, nx); b.st[0] = nloc; b.st[1] = nx; }
        const unsigned old = xb_add(&bar[XB_XSUB(b.x)], 1u);
        const unsigned gen = old / nloc;
        if (old + 1u == (gen + 1u) * nloc) {
            __builtin_amdgcn_fence(__ATOMIC_RELEASE, "agent");
            asm volatile("s_waitcnt vmcnt(0)" ::: "memory");
            const unsigned og = xb_add(&bar[XB_TOP], 1u);
            const unsigned tg = og / nx;
            if (og + 1u == (tg + 1u) * nx) xb_add(&bar[XB_TOPGEN], 1u);
            else XB_SPIN(xb_ld(&bar[XB_TOPGEN]) == tg, bar);
            __builtin_amdgcn_fence(__ATOMIC_ACQUIRE, "agent");
            xb_add(&bar[XB_XGEN(b.x)], 1u);
            asm volatile("s_waitcnt vmcnt(0)" ::: "memory");
        } else {
            XB_SPIN(xb_ld(&bar[XB_XGEN(b.x)]) == gen, bar);
            __builtin_amdgcn_fence(__ATOMIC_ACQUIRE, "agent");
            asm volatile("s_waitcnt vmcnt(0)" ::: "memory");
        }
    }
    __syncthreads();
}

#ifndef AT_REP
#define AT_REP 1
#endif
#ifndef GM_REP
#define GM_REP 1
#endif
__global__ void __launch_bounds__(512, 2) hymba_fwd(P p) {
    extern __shared__ __attribute__((aligned(16))) unsigned char lds_raw[];
    cg::grid_group grid = cg::this_grid();
    LAS unsigned char* lds = (LAS unsigned char*)lds_raw;
    int tid = threadIdx.x, lane = tid & 63, wave = __builtin_amdgcn_readfirstlane(tid >> 6);
#define FRESH() do { int t_ = threadIdx.x; asm volatile("" : "+v"(t_)); tid = t_; lane = t_ & 63; wave = __builtin_amdgcn_readfirstlane(t_ >> 6); } while (0)
    const int lo = p.ph_lo, hi = p.ph_hi;
    volatile LAS unsigned* bst = (volatile LAS unsigned*)(lds + LDS_BYTES - 64);
    if (threadIdx.x < 2) bst[threadIdx.x] = 0u;
    __syncthreads();
    XcdBarrier bar; bar.bar = p.BAR; bar.x = 0; bar.st = bst;
    if (hi - lo > 1) bar = xcd_barrier_post(p.BAR, bst);
    if (hi > 1000) grid.sync();
    unsigned long long tp_sum = 0; (void)tp_sum;
#ifdef TPROBE
    unsigned long long tq = wall_clock64();
#define TQ(k) do { const unsigned long long n_ = wall_clock64(); if (TPROBE == (k)) tp_sum += n_ - tq; tq = n_; } while (0)
#else
#define TQ(k) do {} while (0)
#endif
#define IN(k) (lo <= (k) && (k) < hi)
#define SEAM(k) do { if (IN(k) && IN((k) + 1)) xcd_barrier(bar); } while (0)
#ifndef NO_P0
    if (IN(0)) phase0(p, lds, tid, wave, lane);
#endif
    SEAM(0); TQ(20); FRESH();
#ifndef NO_P1
    if (IN(1)) { phase1(p, wave, lane); phase0b(p, lds, tid, wave, lane); }
#endif
    SEAM(1); TQ(21); FRESH();
#ifndef NO_P2
    if (IN(2)) {
        pg8::Gemm g{p.XN, p.WIN, MP, DIN, DM}; pg8::StaticOrder S; S.init(MP, DIN, (int)gridDim.x, (int)blockIdx.x);
        EpiIn E{p.ZB, p.GVT, p.VT, p.STATS, p.out + OUT_KP, p.out + OUT_VP};
        pg8::gemm_phase<EpiIn, pg8::StaticOrder, true, true>(lds, g, S, E);
        for (int un = blockIdx.x; un < DIN / 16; un += gridDim.x) {
            const int n0 = un * 16; const f32x4 a = small_gemm(p.XN + (size_t)MP * DM, p.WIN, n0, wave, lane);
            const int row = wave * 16 + (lane & 15), c = n0 + 4 * (lane >> 4), seg = c >> 9; float v[4] = {a[0], a[1], a[2], a[3]};
            if (seg <= 1) {
#pragma unroll
                for (int i = 0; i < 4; ++i) v[i] = gelu_t(v[i]); }
            else if (seg == 2 || seg == 6) {
#pragma unroll
                for (int i = 0; i < 4; ++i) v[i] = silu_f(v[i]); }
            else if (seg == 3) {
#pragma unroll
                for (int i = 0; i < 4; ++i) v[i] *= 0.125f; }
            const f32x4 vv = {v[0], v[1], v[2], v[3]};
            *(f32x4*)(p.ZS + (size_t)row * DIN + c) = vv;
            if (seg == 4) *(f32x4*)(p.out + OUT_KS + (size_t)row * 512 + (c - SEG_K)) = vv;
            if (seg == 5) *(f32x4*)(p.out + OUT_VS + (size_t)row * 512 + (c - SEG_VV)) = vv;
        }
    }

#endif
    TQ(30); SEAM(2); TQ(22); FRESH();
    if (IN(3)) {
        LAS float* biasL = (LAS float*)lds;
        for (int i = tid; i < 8 * 257; i += 512) biasL[i] = p.rel_bias[i];
        __syncthreads();
        LAS unsigned char* wl = lds + 16384 + wave * 9216; LAS float* wscr = (LAS float*)wl;
        const int G_ = (int)gridDim.x, vcu = (G_ % 8 == 0) ? ((int)blockIdx.x % 8) * (G_ / 8) + (int)blockIdx.x / 8 : (int)blockIdx.x;
        const int gw = vcu * 8 + wave, NGW = G_ * 8;
        TQ(9);
        if (blockIdx.x < MS) sattn_block(p, (int)blockIdx.x & 7, (int)blockIdx.x >> 3, (LAS float*)(lds + 16384), biasL, wave, lane);
        TQ(11); FRESH();
        { const int xq = G_ % 8 == 0 ? (int)blockIdx.x % 8 : 0, nq = G_ % 8 == 0 ? 8 : 1;
          unsigned* ctr = p.QCTR + 64 * xq;
          const int n_sg = 64 / nq, n_at = 4096 / nq, n_gm = 2048 / nq, n_all = n_sg + n_at + n_gm;
          int nxt = 0; if (lane == 0) nxt = (int)atomicAdd(ctr, 1u); nxt = __builtin_amdgcn_readfirstlane(nxt);
          while (nxt < n_all) {
              const int it = nxt; FRESH();
              if (it < n_sg) { const int un = it * nq + xq; sgmlp_unit(p, un >> 3, un & 7, lane); }
              else if (it < n_sg + n_at) { const int j = it - n_sg, pair = (j >> 8) * nq + xq, ci = j & 255; attn_unit(p, pair >> 3, pair & 7, ci, biasL + (pair & 7) * 257, wl, lane, tp_sum); }
              else { const int un = (it - n_sg - n_at) * nq + xq, n = un & 127, g = (un >> 7) & 7, b = un >> 10; gmlp_unit(p, b, n, g, wscr, lane); }
              { int v = 0; if (lane == 0) v = (int)atomicAdd(ctr, 1u); nxt = __builtin_amdgcn_readfirstlane(v); }
          }
        }
        TQ(13);
    }

    TQ(31); SEAM(3); TQ(23); FRESH();
#ifndef NO_P4
    if (IN(4)) {
        pg8::Gemm g{p.XN, p.WOUT, MP, DM, DM}; pg8::StaticOrder S; S.init(MP, DM, (int)gridDim.x, (int)blockIdx.x);
        EpiOut E{p.x_prompt, p.out + OUT_YP, p.MOD, p.g_post, p.STATS, p.PCNT};
        pg8::gemm_phase<EpiOut, pg8::StaticOrder, true, true>(lds, g, S, E);
        for (int un = blockIdx.x; un < DM / 16; un += gridDim.x) {
            const int n0 = un * 16; const f32x4 a = small_gemm(p.XN + (size_t)MP * DM, p.WOUT, n0, wave, lane);
            *(f32x4*)(p.OS + (size_t)(wave * 16 + (lane & 15)) * DM + n0 + 4 * (lane >> 4)) = a;
        }
    }

#endif
    TQ(32); SEAM(4); TQ(24); FRESH();
#ifndef NO_P5
    if (IN(5)) phase5(p, wave, lane);
#endif
    TQ(25);
#ifdef TPROBE
    if (blockIdx.x == 8 && wave == 0) { const unsigned long long t0 = wall_clock64(); while (wall_clock64() - t0 < 4ull * tp_sum) __builtin_amdgcn_s_sleep(8); }
#endif
#undef IN
#undef SEAM
}

#ifndef N_LAUNCHES
#define N_LAUNCHES 1
#endif
extern "C" void kernel_launch(void* const* d_in, const int* in_sizes, int n_in, void* d_out, int out_size, void* d_ws, size_t ws_size, hipStream_t stream) {
    static int grid = 0;
    if (grid == 0) {
        if (n_in != 17 || ws_size < WS_END) { fprintf(stderr, "kernel_launch: unexpected n_in %d / ws %zu\n", n_in, ws_size); grid = -1; return; }
        int dev = 0, cus = 0, per_cu = 0;
        if (hipGetDevice(&dev) != hipSuccess || hipDeviceGetAttribute(&cus, hipDeviceAttributeMultiprocessorCount, dev) != hipSuccess) { grid = -1; return; }
        if (hipFuncSetAttribute((const void*)hymba_fwd, hipFuncAttributeMaxDynamicSharedMemorySize, LDS_BYTES) != hipSuccess) { fprintf(stderr, "kernel_launch: hipFuncSetAttribute failed\n"); grid = -1; return; }
        if (hipOccupancyMaxActiveBlocksPerMultiprocessor(&per_cu, (const void*)hymba_fwd, 512, LDS_BYTES) != hipSuccess || per_cu < 1) { fprintf(stderr, "kernel_launch: occupancy query says %d\n", per_cu); grid = -1; return; }
        grid = cus;
    }
    if (grid < 0) return;
    P p{};
    const float** in = (const float**)&p.x_prompt;
    for (int i = 0; i < 17; ++i) in[i] = (const float*)d_in[i];
    unsigned char* ws = (unsigned char*)d_ws;
    p.out = (float*)d_out;
    p.MOD = (float*)(ws + WS_MOD); p.WIN = (bf16_t*)(ws + WS_WIN); p.WOUT = (bf16_t*)(ws + WS_WOUT); p.WST = (bf16_t*)(ws + WS_WST); p.STATS = (float*)(ws + WS_STATS);
    p.XN = (bf16_t*)(ws + WS_XN); p.ZB = (bf16_t*)(ws + WS_ZB); p.GVT = (bf16_t*)(ws + WS_GVT); p.VT = (bf16_t*)(ws + WS_VT); p.OB = (bf16_t*)(ws + WS_OB);
    p.ZS = (float*)(ws + WS_ZS); p.OS = (float*)(ws + WS_OS); p.QCTR = (unsigned*)(ws + WS_QCTR); p.PCNT = (unsigned*)(ws + WS_PCNT); p.BAR = (unsigned*)(ws + WS_BAR);
    if (hipMemsetAsync(ws + WS_BAR, 0, 16384, stream) != hipSuccess) { fprintf(stderr, "kernel_launch: memset failed\n"); return; }
#if N_LAUNCHES == 1
    p.ph_lo = 0; p.ph_hi = 6;
    void* args[] = {&p};
    hipError_t e = hipLaunchCooperativeKernel((const void*)hymba_fwd, dim3(grid), dim3(512), args, LDS_BYTES, stream);
    if (e != hipSuccess) fprintf(stderr, "kernel_launch: cooperative launch failed: %s (grid %d)\n", hipGetErrorString(e), grid);
#else
#ifndef PROBE_REP
#define PROBE_REP -1
#endif
    for (int ph = 0; ph < 6; ++ph) { p.ph_lo = ph; p.ph_hi = ph + 1;
        for (int rep = 0; rep < (ph == PROBE_REP ? 2 : 1); ++rep) hipLaunchKernelGGL(hymba_fwd, dim3(grid), dim3(512), LDS_BYTES, stream, p); }
#endif
}
```

```cpp
#include <hip/hip_runtime.h>
#include <hip/hip_cooperative_groups.h>
#include <cstdio>
#include <cstdint>
namespace cg = cooperative_groups;
namespace pg8 {
#define PG8_LAS __attribute__((address_space(3)))
typedef unsigned short bf16_t;
typedef short bf16x8 __attribute__((ext_vector_type(8)));
typedef float f32x4 __attribute__((ext_vector_type(4)));
typedef unsigned u32x4 __attribute__((ext_vector_type(4)));
constexpr int BM = 256, BK = 64, HALF = 128, HTB = HALF * BK * 2  , STAGE_BYTES = 8 * HTB, NXCD = 8, WGM = 8;

__host__ __device__ __forceinline__ int lds_byte(int r, int c) { const int st = (r >> 4) * 2 + (c >> 5), rr = r & 15, cc = c & 31, ob = rr * 64 + cc * 2; return st * 1024 + (ob ^ (((ob >> 9) & 1) << 5)); }
__host__ __device__ __forceinline__ void stage_rc(int b, int& R, int& C) { const int st = b / 1024, sb = b % 1024, swz = sb ^ (((sb >> 9) & 1) << 5); R = (st >> 1) * 16 + swz / 64; C = (st & 1) * 32 + (swz % 64) / 2; }
__host__ __device__ __forceinline__ int perm32(int rho) { const int n = rho >> 4, i = rho & 15; return 8 * (i >> 2) + 4 * n + (i & 3); }

struct Unit { int pm, pn; };
struct Gemm { const bf16_t* A; const bf16_t* Bt; int M, N, K; };

struct StaticOrder {
    int nM, nN, nwg, G, c;
    __host__ __device__ void init(int M, int N, int G_, int c_) { nM = M / BM; nN = N / BM; nwg = nM * nN; G = G_; c = c_; }
    __host__ __device__ bool next(int i, Unit& u) const {
        const long L = (long)i * G + c; if (L >= nwg) return false;
        int wgid = (int)L; { const int q = nwg / NXCD, r = nwg % NXCD, xcd = wgid % NXCD, off = wgid / NXCD; wgid = (xcd < r ? xcd * (q + 1) : r * (q + 1) + (xcd - r) * q) + off; }
        const int nig = WGM * nN, gid = wgid / nig, fm = gid * WGM, gsz = (nM - fm) < WGM ? (nM - fm) : WGM;
        u.pm = fm + ((wgid % nig) % gsz); u.pn = (wgid % nig) / gsz; return true;
    }
    __device__ __forceinline__ void a_ready(const Unit&) const {}
    __device__ __forceinline__ void done(const Unit&) const {}
};

__device__ __forceinline__ unsigned cvt_pk_bf16(float lo, float hi) { unsigned r; asm volatile("v_cvt_pk_bf16_f32 %0, %1, %2" : "=v"(r) : "v"(lo), "v"(hi)); return r; }
typedef float f32x2 __attribute__((ext_vector_type(2)));
template <class Epi, class Sched, bool ALIGN_EPI = false, bool SP2 = false>
__device__ __forceinline__ void gemm_phase(PG8_LAS unsigned char* lds, const Gemm g, const Sched& S, const Epi& E) {
    const int tid = threadIdx.x, wid = __builtin_amdgcn_readfirstlane(tid >> 6), lane = tid & 63, wr = wid >> 2, wc = wid & 3, fr = lane & 15, fq = lane >> 4;
    const int K = g.K, nt = K / BK;
    unsigned voffA[2], voffB[2];
#pragma unroll
    for (int i = 0; i < 2; ++i) { int R, C; stage_rc(tid * 16 + i * 8192, R, C); const int Rb = Epi::PERM ? ((R & ~31) + perm32(R & 31)) : R;
        voffA[i] = (unsigned)(R * K + C) * 2u; voffB[i] = (unsigned)(Rb * K + C) * 2u; }
    const size_t kstep = (size_t)(BK * 2);
    const size_t hstep = (size_t)HALF * K * 2;
    const size_t tstep = 2 * hstep;
    const unsigned ldsw = (unsigned)wid * 1024u;
    const int aoff = lds_byte(wr * 64 + fr, fq * 8), boff = lds_byte(wc * 32 + fr, fq * 8);
#define PG8_SA(b, h) (((b) * 2 + (h)) * HTB)
#define PG8_SB(b, h) ((4 + (b) * 2 + (h)) * HTB)
#define PG8_STAGE(bufoff, gbase, voff) do { _Pragma("unroll") for (int _i = 0; _i < 2; ++_i) \
        __builtin_amdgcn_global_load_lds((const unsigned*)((const char*)(gbase) + (voff)[_i]), (PG8_LAS unsigned*)(lds + (bufoff) + ldsw + _i * 8192), 16, 0, 0); } while (0)
#define PG8_LDA(dst, b, h) do { _Pragma("unroll") for (int m = 0; m < 4; ++m) _Pragma("unroll") for (int k = 0; k < 2; ++k) dst[m][k] = *(const PG8_LAS bf16x8*)(lds + PG8_SA(b, h) + aoff + m * 2048 + k * 1024); } while (0)
#define PG8_LDB(dst, b, h) do { _Pragma("unroll") for (int n = 0; n < 2; ++n) _Pragma("unroll") for (int k = 0; k < 2; ++k) dst[n][k] = *(const PG8_LAS bf16x8*)(lds + PG8_SB(b, h) + boff + n * 2048 + k * 1024); } while (0)
#define PG8_MMA(ai, bj, At, Bt) do { __builtin_amdgcn_s_setprio(1); _Pragma("unroll") for (int m = 0; m < 4; ++m) _Pragma("unroll") for (int n = 0; n < 2; ++n) _Pragma("unroll") for (int k = 0; k < 2; ++k) \
        acc[ai][bj][m][n] = __builtin_amdgcn_mfma_f32_16x16x32_bf16(Bt[n][k], At[m][k], acc[ai][bj][m][n], 0, 0, 0); __builtin_amdgcn_s_setprio(0); } while (0)
#define PG8_WAIT_V(n) asm volatile("s_waitcnt vmcnt(" #n ")" ::: "memory")
#define PG8_WAIT_L(n) asm volatile("s_waitcnt lgkmcnt(" #n ")" ::: "memory")
#define PG8_BAR __builtin_amdgcn_s_barrier()
#define PG8_SCHED __builtin_amdgcn_sched_barrier(0)
    Unit cur, nxt; int ui = 0;
    if (!S.next(0, cur)) return;
    f32x4 acc[2][2][4][2];
#pragma unroll
    for (int a = 0; a < 2; ++a)
#pragma unroll
        for (int b = 0; b < 2; ++b)
#pragma unroll
            for (int m = 0; m < 4; ++m)
#pragma unroll
                for (int n = 0; n < 2; ++n) acc[a][b][m][n] = (f32x4){0.f, 0.f, 0.f, 0.f};
    bf16x8 At[4][2], B0[2][2], B1[2][2];
    const char* cA = (const char*)g.A + (size_t)cur.pm * tstep; const char* cB = (const char*)g.Bt + (size_t)cur.pn * tstep;
    S.a_ready(cur);
    if constexpr (SP2) {
        PG8_STAGE(PG8_SB(0, 0), cB, voffB); PG8_STAGE(PG8_SB(0, 1), cB + hstep, voffB); PG8_STAGE(PG8_SA(0, 0), cA, voffA); PG8_STAGE(PG8_SA(0, 1), cA + hstep, voffA);
        if (wr == 1) PG8_BAR;
        PG8_WAIT_V(2); PG8_BAR;
        PG8_STAGE(PG8_SB(1, 0), cB + kstep, voffB); PG8_STAGE(PG8_SA(1, 0), cA + kstep, voffA); PG8_STAGE(PG8_SB(1, 1), cB + hstep + kstep, voffB);
        PG8_WAIT_V(6); PG8_BAR;
    } else {
        PG8_STAGE(PG8_SB(0, 0), cB, voffB); PG8_STAGE(PG8_SA(0, 0), cA, voffA); PG8_STAGE(PG8_SB(0, 1), cB + hstep, voffB); PG8_STAGE(PG8_SA(0, 1), cA + hstep, voffA);
        if (wr == 1) PG8_BAR;
        PG8_WAIT_V(4); PG8_BAR;
        PG8_STAGE(PG8_SB(1, 0), cB + kstep, voffB); PG8_STAGE(PG8_SA(1, 0), cA + kstep, voffA); PG8_STAGE(PG8_SB(1, 1), cB + hstep + kstep, voffB);
        PG8_WAIT_V(6); PG8_BAR;
    }
    for (;;) {
        const bool has_next = S.next(ui + 1, nxt);
        const char* nA = has_next ? (const char*)g.A + (size_t)nxt.pm * tstep : cA; const char* nB = has_next ? (const char*)g.Bt + (size_t)nxt.pn * tstep : cB;
        for (int t = 0; t < nt; t += 2) {
            const bool last = (t == nt - 2);
            const char* a1 = cA + (size_t)(t + 1) * kstep;
            const char* a2 = last ? nA : cA + (size_t)(t + 2) * kstep; const char* b2 = last ? nB : cB + (size_t)(t + 2) * kstep;
            const char* a3 = a2 + kstep; const char* b3 = b2 + kstep;
            if (last && has_next) S.a_ready(nxt);
            if constexpr (SP2) {
            PG8_LDB(B0, 0, 0); PG8_LDB(B1, 0, 1); PG8_SCHED; PG8_LDA(At, 0, 0); PG8_STAGE(PG8_SA(1, 1), a1 + hstep, voffA);
            PG8_WAIT_V(8); PG8_WAIT_L(0); PG8_BAR; PG8_MMA(0, 0, At, B0); PG8_MMA(0, 1, At, B1); PG8_BAR; PG8_SCHED;
            PG8_LDA(At, 0, 1); PG8_STAGE(PG8_SB(0, 0), b2, voffB); PG8_STAGE(PG8_SB(0, 1), b2 + hstep, voffB); PG8_STAGE(PG8_SA(0, 0), a2, voffA);
            PG8_WAIT_V(8); PG8_WAIT_L(0); PG8_BAR; PG8_MMA(1, 0, At, B0); PG8_MMA(1, 1, At, B1); PG8_BAR; PG8_SCHED;
            PG8_LDB(B0, 1, 0); PG8_LDB(B1, 1, 1); PG8_SCHED; PG8_LDA(At, 1, 0); PG8_STAGE(PG8_SA(0, 1), a2 + hstep, voffA);
            PG8_WAIT_V(8); PG8_WAIT_L(0); PG8_BAR; PG8_MMA(0, 0, At, B0); PG8_MMA(0, 1, At, B1); PG8_BAR; PG8_SCHED;
            PG8_LDA(At, 1, 1); PG8_STAGE(PG8_SB(1, 0), b3, voffB); PG8_STAGE(PG8_SB(1, 1), b3 + hstep, voffB); PG8_STAGE(PG8_SA(1, 0), a3, voffA);
            PG8_WAIT_V(8); PG8_WAIT_L(0); PG8_BAR; PG8_MMA(1, 0, At, B0); PG8_MMA(1, 1, At, B1); PG8_BAR; PG8_SCHED;
            } else {
            PG8_LDB(B0, 0, 0); PG8_SCHED; PG8_LDA(At, 0, 0); PG8_STAGE(PG8_SA(1, 1), a1 + hstep, voffA);
            PG8_WAIT_L(8); PG8_BAR; PG8_WAIT_L(0); PG8_MMA(0, 0, At, B0); PG8_BAR; PG8_SCHED;
            PG8_LDB(B1, 0, 1); PG8_STAGE(PG8_SB(0, 0), b2, voffB);
            PG8_BAR; PG8_WAIT_L(0); PG8_MMA(0, 1, At, B1); PG8_BAR;
            PG8_LDA(At, 0, 1); PG8_STAGE(PG8_SA(0, 0), a2, voffA);
            PG8_BAR; PG8_WAIT_L(0); PG8_MMA(1, 0, At, B0); PG8_BAR; PG8_SCHED;
            PG8_STAGE(PG8_SB(0, 1), b2 + hstep, voffB);
            PG8_WAIT_V(6); PG8_BAR; PG8_MMA(1, 1, At, B1); PG8_BAR;
            PG8_LDB(B0, 1, 0); PG8_SCHED; PG8_LDA(At, 1, 0); PG8_STAGE(PG8_SA(0, 1), a2 + hstep, voffA);
            PG8_WAIT_L(8); PG8_BAR; PG8_WAIT_L(0); PG8_MMA(0, 0, At, B0); PG8_BAR; PG8_SCHED;
            PG8_LDB(B1, 1, 1); PG8_STAGE(PG8_SB(1, 0), b3, voffB);
            PG8_BAR; PG8_WAIT_L(0); PG8_MMA(0, 1, At, B1); PG8_BAR;
            PG8_LDA(At, 1, 1); PG8_STAGE(PG8_SA(1, 0), a3, voffA);
            PG8_BAR; PG8_WAIT_L(0); PG8_MMA(1, 0, At, B0); PG8_BAR; PG8_SCHED;
            PG8_STAGE(PG8_SB(1, 1), b3 + hstep, voffB);
            PG8_WAIT_V(6); PG8_BAR; PG8_MMA(1, 1, At, B1); PG8_BAR;
            }
        }
        if constexpr (ALIGN_EPI) { if (wr == 0) PG8_BAR; }
        if constexpr (!Epi::AFTER_DRAIN) { E(acc, cur, wr, wc, fr, fq); S.done(cur); }
        if (!has_next) break;
#pragma unroll
        for (int a = 0; a < 2; ++a)
#pragma unroll
            for (int b = 0; b < 2; ++b)
#pragma unroll
                for (int m = 0; m < 4; ++m)
#pragma unroll
                    for (int n = 0; n < 2; ++n) acc[a][b][m][n] = (f32x4){0.f, 0.f, 0.f, 0.f};
        cur = nxt; cA = nA; cB = nB; ++ui;
        if constexpr (ALIGN_EPI) { if (wr == 1) PG8_BAR; }
    }
    PG8_WAIT_V(0);
    if constexpr (!ALIGN_EPI) { if (wr == 0) PG8_BAR; }
    PG8_BAR;
    if constexpr (Epi::AFTER_DRAIN) { E.fused(acc, cur, wr, wc, fr, fq, lds, wid, lane); S.done(cur); }
#undef PG8_SA
#undef PG8_SB
#undef PG8_STAGE
#undef PG8_LDA
#undef PG8_LDB
#undef PG8_MMA
#undef PG8_WAIT_V
#undef PG8_WAIT_L
#undef PG8_BAR
#undef PG8_SCHED
}
}

using pg8::bf16_t; using pg8::bf16x8; using pg8::f32x4; using pg8::u32x4;
#define GAS __attribute__((address_space(1)))
#define LAS __attribute__((address_space(3)))
typedef unsigned v4u __attribute__((ext_vector_type(4)));
typedef unsigned u32x2 __attribute__((ext_vector_type(2)));
typedef float f32x16 __attribute__((ext_vector_type(16)));
typedef float f32x2_t __attribute__((ext_vector_type(2)));
typedef __bf16 bf16x2_t __attribute__((ext_vector_type(2)));
#define LDS_WAIT() asm volatile("s_waitcnt lgkmcnt(0)" ::: "memory")
__device__ __forceinline__ unsigned f2bf(float f) { unsigned u = __builtin_bit_cast(unsigned, f); return (u + 0x7fffu + ((u >> 16) & 1u)) >> 16; }
__device__ __forceinline__ unsigned pk2(float lo, float hi) { return f2bf(lo) | (f2bf(hi) << 16); }
__device__ __forceinline__ unsigned pkbf(float lo, float hi) { f32x2_t v = {lo, hi}; bf16x2_t b = __builtin_convertvector(v, bf16x2_t); return __builtin_bit_cast(unsigned, b); }
__device__ __forceinline__ float bflo(unsigned w) { return __uint_as_float(w << 16); }
__device__ __forceinline__ float bfhi(unsigned w) { return __uint_as_float(w & 0xffff0000u); }
__device__ __forceinline__ float wave_sum(float v) {
#pragma unroll
    for (int o = 1; o < 64; o <<= 1) v += __shfl_xor(v, o);
    return v;
}
__device__ __forceinline__ float wave_max(float v) {
#pragma unroll
    for (int o = 1; o < 64; o <<= 1) v = fmaxf(v, __shfl_xor(v, o));
    return v;
}
__device__ __forceinline__ float gelu_t(float x) {
    const float u = 0.7978845608028654f * (x + 0.044715f * x * x * x);
    return x * __builtin_amdgcn_rcpf(1.f + __expf(-2.f * u));
}
__device__ __forceinline__ float silu_f(float x) { return x * __builtin_amdgcn_rcpf(1.f + __expf(-x)); }

constexpr int DM = 1024, T = 16384, NB = 2, MP = NB * T, SBT = 8, STT = 16, MS = SBT * STT, DIN = 3584;
constexpr int SEG_U = 0, SEG_V = 512, SEG_G = 1024, SEG_Q = 1536, SEG_K = 2048, SEG_VV = 2560, SEG_GB = 3072;
constexpr float EPS = 1e-6f;
constexpr size_t OUT_YP = 0, OUT_YS = 33554432, OUT_KP = 33685504, OUT_VP = 34209792, OUT_KS = 34734080, OUT_VS = 34799616, OUT_GV = 34865152;
constexpr size_t MiB = 1u << 20;
constexpr size_t WS_MOD = 0, WS_QCTR = 512 * 1024, WS_PCNT = 640 * 1024, WS_BAR = 768 * 1024, WS_WIN = 1 * MiB, WS_WOUT = 8 * MiB, WS_WST = 10 * MiB, WS_STATS = 11 * MiB, WS_XN = 16 * MiB, WS_ZB = 96 * MiB,
                 WS_GVT = 320 * MiB, WS_VT = 352 * MiB, WS_OB = 384 * MiB, WS_ZS = 448 * MiB, WS_OS = 450 * MiB, WS_END = 451 * MiB;
constexpr int LDS_BYTES = 147456;
__device__ __forceinline__ size_t zb_off(int seg, int b, int hg, int t) { return ((((size_t)seg * 2 + b) * 8 + hg) * T + t) * 64; }

struct P {
    const float *x_prompt, *x_sample, *cache_k, *cache_v, *c_prompt, *c_sample, *g_pre, *w_ada, *b_ada, *w_in, *ln_g, *ln_b, *w_s, *b_s, *rel_bias, *w_out, *g_post;
    float* out;
    float* MOD; bf16_t* WIN; bf16_t* WOUT; bf16_t* WST; float* STATS; bf16_t* XN; bf16_t* ZB; bf16_t* GVT; bf16_t* VT; bf16_t* OB; float* ZS; float* OS; unsigned* QCTR; unsigned* PCNT; unsigned* BAR;
    int ph_lo, ph_hi;
};
__device__ __forceinline__ void p0_transpose_item(const float* W, int K, int N, bf16_t* WT, int row_off, LAS float* scr, int item, int lane) {
    const int nblk = N / 32, kb = item / nblk, nb = item % nblk, k0 = 64 * kb, n0 = 32 * nb;
#pragma unroll
    for (int i = 0; i < 32; ++i) { const int kk = 2 * i + (lane >> 5); scr[kk * 33 + (lane & 31)] = W[(size_t)(k0 + kk) * N + n0 + (lane & 31)]; }
    LDS_WAIT(); asm volatile("" ::: "memory");
    const int c = lane & 7;
#pragma unroll
    for (int j = 0; j < 4; ++j) { const int n = (lane >> 3) + 8 * j; const LAS float* s = scr + (8 * c) * 33 + n;
        v4u o; o.x = pk2(s[0 * 33], s[1 * 33]); o.y = pk2(s[2 * 33], s[3 * 33]); o.z = pk2(s[4 * 33], s[5 * 33]); o.w = pk2(s[6 * 33], s[7 * 33]);
        *(GAS v4u*)(WT + (size_t)(row_off + n0 + n) * K + k0 + 8 * c) = o; }
    LDS_WAIT(); asm volatile("" ::: "memory");
}
__device__ __forceinline__ void phase0(const P& p, LAS unsigned char* lds, int tid, int wave, int lane) {
    if (blockIdx.x < 192) {
        LAS float* sc = (LAS float*)lds;
        LAS float* red = sc + 10240;
        for (int i = tid; i < 10240; i += 512) { const int b = i >> 10, k = i & 1023; const float c = b < 2 ? p.c_prompt[b * 1024 + k] : p.c_sample[(b - 2) * 1024 + k]; sc[i] = silu_f(c); }
        __syncthreads();
        const int j0 = blockIdx.x * 16, j = lane & 15, ks = lane >> 4;
        float acc[10];
#pragma unroll
        for (int b = 0; b < 10; ++b) acc[b] = 0.f;
#pragma unroll
        for (int i = 0; i < 32; ++i) { const int k = wave * 128 + i * 4 + ks; const float w = p.w_ada[(size_t)k * 3072 + j0 + j];
#pragma unroll
            for (int b = 0; b < 10; ++b) acc[b] += sc[b * 1024 + k] * w; }
#pragma unroll
        for (int b = 0; b < 10; ++b) { acc[b] += __shfl_xor(acc[b], 16); acc[b] += __shfl_xor(acc[b], 32); }
        if (lane < 16) {
#pragma unroll
            for (int b = 0; b < 10; ++b) red[(wave * 10 + b) * 16 + j] = acc[b]; }
        __syncthreads();
        if (tid < 160) { const int b = tid >> 4, jj = tid & 15; float s = p.b_ada[j0 + jj];
#pragma unroll
            for (int w = 0; w < 8; ++w) s += red[(w * 10 + b) * 16 + jj];
            p.MOD[b * 3072 + j0 + jj] = s; }
        __syncthreads();
    }
}

__device__ __forceinline__ void phase0b(const P& p, LAS unsigned char* lds, int tid, int wave, int lane) {
    if (blockIdx.x == 0 && tid < 8) p.QCTR[64 * tid] = 0u;
    if (blockIdx.x == 1 && tid < 128) p.PCNT[64 * tid] = 0u;
    LAS float* scr = (LAS float*)(lds + wave * 16384);
    const int gw = blockIdx.x * 8 + wave, NGW = gridDim.x * 8;
    constexpr int I_IN = (DM / 64) * (DIN / 32), I_OUT = (DM / 64) * (DM / 32);
    for (int it = gw; it < I_IN + I_OUT; it += NGW) {
        if (it < I_IN) {
            const int n0 = 32 * (it % (DIN / 32)); int np = n0;
            if (n0 < 512) np = 256 * (n0 >> 7) + (n0 & 127); else if (n0 < 1024) np = n0 + 512; else if (n0 < 1536) np = 256 * ((n0 - 1024) >> 7) + 128 + ((n0 - 1024) & 127);
            p0_transpose_item(p.w_in, DM, DIN, p.WIN, np - n0, scr, it, lane); }
        else p0_transpose_item(p.w_out, DM, DM, p.WOUT, 0, scr, it - I_IN, lane);
    }
    for (int i = blockIdx.x * 512 + tid; i < 8 * 128 * 128; i += gridDim.x * 512) { const int t = (i >> 7) & 127, s = i & 127; p.WST[i] = (bf16_t)f2bf(s <= t ? p.w_s[i] : 0.f); }
}

__device__ __forceinline__ const float* p1_row(const P& p, int m) { return m < MP ? p.x_prompt + (size_t)m * DM : p.x_sample + (size_t)(m - MP) * DM; }
__device__ __forceinline__ void phase1(const P& p, int wave, int lane) {
    const int gw = blockIdx.x * 8 + wave, NGW = gridDim.x * 8, NR = MP + MS, RPW = (NR + NGW - 1) / NGW;
    const int m0 = gw * RPW, m1 = (m0 + RPW < NR) ? m0 + RPW : NR;
    constexpr int PD = 4;
    f32x4 v[4], nx[PD][4];
#pragma unroll
    for (int d = 0; d < PD; ++d) if (m0 + d < m1) { const f32x4* xr = (const f32x4*)p1_row(p, m0 + d) + lane;
#pragma unroll
        for (int j = 0; j < 4; ++j) nx[d][j] = xr[64 * j]; }
    f32x4 ga[4], sh[4]; int bcur = -1;
    for (int m = m0; m < m1; ++m) {
#pragma unroll
        for (int j = 0; j < 4; ++j) { v[j] = nx[0][j];
#pragma unroll
            for (int d = 0; d + 1 < PD; ++d) nx[d][j] = nx[d + 1][j]; }
        if (m + PD < m1) { const f32x4* xr = (const f32x4*)p1_row(p, m + PD) + lane;
#pragma unroll
            for (int j = 0; j < 4; ++j) nx[PD - 1][j] = xr[64 * j]; }
        const int b = m < MP ? (m >> 14) : 2 + ((m - MP) >> 4);
        if (b != bcur) { bcur = b; const float* mod = p.MOD + b * 3072;
#pragma unroll
            for (int j = 0; j < 4; ++j) { const int c = 4 * lane + 256 * j; ga[j] = *(const f32x4*)(p.g_pre + c) * (*(const f32x4*)(mod + 1024 + c) + 1.f); sh[j] = *(const f32x4*)(mod + c); } }
        float s = 0.f;
#pragma unroll
        for (int j = 0; j < 4; ++j) s += (v[j].x * v[j].x + v[j].y * v[j].y) + (v[j].z * v[j].z + v[j].w * v[j].w);
        const float rstd = rsqrtf(wave_sum(s) * (1.f / DM) + EPS);
        u32x2* o8 = (u32x2*)(p.XN + (size_t)m * DM) + lane;
#pragma unroll
        for (int j = 0; j < 4; ++j) { const f32x4 hh = v[j] * rstd * ga[j] + sh[j];
            u32x2 w; w.x = pkbf(hh.x, hh.y); w.y = pkbf(hh.z, hh.w); o8[64 * j] = w; }
    }
}

struct EpiIn {
    static constexpr bool PERM = true, AFTER_DRAIN = false;
    bf16_t* ZB; bf16_t* GVT; bf16_t* VT; float* STATS; float* outK; float* outV;
    __device__ __forceinline__ void operator()(const f32x4 (&acc)[2][2][4][2], const pg8::Unit& u, int wr, int wc, int fr, int fq) const {
        const int seg = u.pn < 4 ? 7 : (u.pn < 6 ? 1 : u.pn >> 1), cs0 = (u.pn & 1) * 256 + wc * 32 + 8 * fq, row0 = u.pm * 256 + wr * 64 + fr;
        if (seg == 7) {
            const int ch = u.pn * 128 + wc * 32 + 8 * fq;
#pragma unroll
            for (int ai = 0; ai < 2; ++ai)
#pragma unroll
                for (int m = 0; m < 4; ++m) { const int row = row0 + ai * 128 + m * 16, b = row >> 14, t = row & (T - 1); float v[8];
#pragma unroll
                    for (int i = 0; i < 4; ++i) { v[i] = gelu_t(acc[ai][0][m][0][i]) * silu_f(acc[ai][1][m][0][i]); v[4 + i] = gelu_t(acc[ai][0][m][1][i]) * silu_f(acc[ai][1][m][1][i]); }
                    u32x4 w; w.x = pkbf(v[0], v[1]); w.y = pkbf(v[2], v[3]); w.z = pkbf(v[4], v[5]); w.w = pkbf(v[6], v[7]);
                    *(u32x4*)(ZB + zb_off(0, b, ch >> 6, t) + (ch & 63)) = w; }
        } else if (seg == 1 || seg == 5) {
#pragma unroll
            for (int ai = 0; ai < 2; ++ai)
#pragma unroll
                for (int m = 0; m < 4; ++m) { const int row = row0 + ai * 128 + m * 16, b = row >> 14, t = row & (T - 1);
                    float s1 = 0.f, s2 = 0.f;
#pragma unroll
                    for (int bj = 0; bj < 2; ++bj) { const int cs = cs0 + bj * 128; float v[8];
#pragma unroll
                        for (int i = 0; i < 4; ++i) { v[i] = acc[ai][bj][m][0][i]; v[4 + i] = acc[ai][bj][m][1][i]; }
                        if (seg == 1) {
#pragma unroll
                            for (int i = 0; i < 8; ++i) { v[i] = gelu_t(v[i]); s1 += v[i]; s2 += v[i] * v[i]; } }
                        else if (t >= T - 512) { float* o = outV + ((size_t)(b * 512 + t - (T - 512))) * 512 + cs;
                            *(f32x4*)o = (f32x4){v[0], v[1], v[2], v[3]}; *(f32x4*)(o + 4) = (f32x4){v[4], v[5], v[6], v[7]}; }
                        bf16_t* d = (seg == 1) ? GVT + (((size_t)(b * 128 + (t >> 7))) * 512 + cs) * 128 + (t & 127) : VT + ((((size_t)(b * 8 + (cs >> 6))) * 256 + (t >> 6)) * 64 + (cs & 63)) * 64 + (t & 63);
                        const int ds = (seg == 1) ? 128 : 64;
#pragma unroll
                        for (int i = 0; i < 4; ++i) { const unsigned w = pkbf(v[2 * i], v[2 * i + 1]); d[(2 * i) * ds] = (bf16_t)(w & 0xffffu); d[(2 * i + 1) * ds] = (bf16_t)(w >> 16); }
                    }
                    if (seg == 1) { s1 += __shfl_xor(s1, 16); s1 += __shfl_xor(s1, 32); s2 += __shfl_xor(s2, 16); s2 += __shfl_xor(s2, 32);
                        if (fq == 0) { f32x2_t sv = {s1, s2}; *(f32x2_t*)(STATS + (size_t)row * 16 + ((u.pn & 1) * 4 + wc) * 2) = sv; } }
                }
        } else {
#pragma unroll
            for (int ai = 0; ai < 2; ++ai)
#pragma unroll
                for (int m = 0; m < 4; ++m) { const int row = row0 + ai * 128 + m * 16, b = row >> 14, t = row & (T - 1);
#pragma unroll
                    for (int bj = 0; bj < 2; ++bj) { const int cs = cs0 + bj * 128; float v[8];
#pragma unroll
                        for (int i = 0; i < 4; ++i) { v[i] = acc[ai][bj][m][0][i]; v[4 + i] = acc[ai][bj][m][1][i]; }
                        if (seg == 0) {
#pragma unroll
                            for (int i = 0; i < 8; ++i) v[i] = gelu_t(v[i]); }
                        else if (seg == 2 || seg == 6) {
#pragma unroll
                            for (int i = 0; i < 8; ++i) v[i] = silu_f(v[i]); }
                        else if (seg == 3) {
#pragma unroll
                            for (int i = 0; i < 8; ++i) v[i] *= 0.125f; }
                        else if (t >= T - 512) { float* o = outK + ((size_t)(b * 512 + t - (T - 512))) * 512 + cs;
                            *(f32x4*)o = (f32x4){v[0], v[1], v[2], v[3]}; *(f32x4*)(o + 4) = (f32x4){v[4], v[5], v[6], v[7]}; }
                        u32x4 w; w.x = pkbf(v[0], v[1]); w.y = pkbf(v[2], v[3]); w.z = pkbf(v[4], v[5]); w.w = pkbf(v[6], v[7]);
                        *(u32x4*)(ZB + zb_off(seg, b, cs >> 6, t) + (cs & 63)) = w; }
                }
        }
    }
};
struct EpiOut {
    static constexpr bool PERM = true, AFTER_DRAIN = false;
    const float* x; float* y; const float* MOD; const float* g_post; float* slot; unsigned* cnt;
    __device__ __forceinline__ void operator()(const f32x4 (&acc)[2][2][4][2], const pg8::Unit& u, int wr, int wc, int fr, int fq) const {
        const int c0 = u.pn * 256 + wc * 32 + 8 * fq, row0 = u.pm * 256 + wr * 64 + fr;
        float ssq[2][4];
#pragma unroll
        for (int ai = 0; ai < 2; ++ai)
#pragma unroll
            for (int m = 0; m < 4; ++m) { float s = 0.f;
#pragma unroll
                for (int bj = 0; bj < 2; ++bj)
#pragma unroll
                    for (int n = 0; n < 2; ++n) { const f32x4 v = acc[ai][bj][m][n]; s += (v[0] * v[0] + v[1] * v[1]) + (v[2] * v[2] + v[3] * v[3]); }
                s += __shfl_xor(s, 16); s += __shfl_xor(s, 32); ssq[ai][m] = s; }
        if (fq == 0) {
#pragma unroll
            for (int ai = 0; ai < 2; ++ai)
#pragma unroll
                for (int m = 0; m < 4; ++m) __hip_atomic_store(slot + (size_t)(row0 + ai * 128 + m * 16) * 16 + u.pn * 4 + wc, ssq[ai][m], __ATOMIC_RELAXED, __HIP_MEMORY_SCOPE_AGENT); }
        asm volatile("s_waitcnt vmcnt(0)" ::: "memory");
        unsigned* pc = cnt + 64 * u.pm;
        if (fq == 0 && fr == 0) __hip_atomic_fetch_add(pc, 1u, __ATOMIC_RELAXED, __HIP_MEMORY_SCOPE_AGENT);
        const float* gate = MOD + (u.pm >> 6) * 3072 + 2048;
        f32x4 gg[2][2];
#pragma unroll
        for (int bj = 0; bj < 2; ++bj)
#pragma unroll
            for (int n = 0; n < 2; ++n) gg[bj][n] = *(const f32x4*)(gate + c0 + bj * 128 + 4 * n) * *(const f32x4*)(g_post + c0 + bj * 128 + 4 * n);
        const unsigned voff = (unsigned)((wr * 64 + fr) * DM + c0) * 4u;
        const char* xb = (const char*)(x + (size_t)(u.pm * 256) * DM); char* yb = (char*)(y + (size_t)(u.pm * 256) * DM);
        f32x4 xa[3][2][2];
#pragma unroll
        for (int k = 0; k < 3; ++k)
#pragma unroll
            for (int bj = 0; bj < 2; ++bj)
#pragma unroll
                for (int n = 0; n < 2; ++n) xa[k][bj][n] = *(const f32x4*)(xb + (size_t)(k * 16) * DM * 4 + voff + (bj * 128 + 4 * n) * 4);
        { unsigned spins = 0;
          while ((unsigned)__builtin_amdgcn_readfirstlane((int)__hip_atomic_load(pc, __ATOMIC_RELAXED, __HIP_MEMORY_SCOPE_AGENT)) < 32u) { __builtin_amdgcn_s_sleep(2); if (++spins > (1u << 24)) break; } }
        asm volatile("" ::: "memory");
        float rstd[2][4];
#pragma unroll
        for (int ai = 0; ai < 2; ++ai)
#pragma unroll
            for (int m = 0; m < 4; ++m) { const unsigned long long* sp = (const unsigned long long*)((const char*)(slot + (size_t)(u.pm * 256 + ai * 128 + m * 16) * 16) + (unsigned)((wr * 64 + fr) * 16 + 4 * fq) * 4u);
                const unsigned long long w0 = __hip_atomic_load(sp, __ATOMIC_RELAXED, __HIP_MEMORY_SCOPE_AGENT), w1 = __hip_atomic_load(sp + 1, __ATOMIC_RELAXED, __HIP_MEMORY_SCOPE_AGENT);
                float t = (__uint_as_float((unsigned)w0) + __uint_as_float((unsigned)(w0 >> 32))) + (__uint_as_float((unsigned)w1) + __uint_as_float((unsigned)(w1 >> 32)));
                rstd[ai][m] = t; }
#pragma unroll
        for (int ai = 0; ai < 2; ++ai)
#pragma unroll
            for (int m = 0; m < 4; ++m) { float t = rstd[ai][m]; t += __shfl_xor(t, 16); t += __shfl_xor(t, 32); rstd[ai][m] = rsqrtf(t * (1.f / DM) + EPS); }
#pragma unroll
        for (int k = 0; k < 8; ++k) { const int ai = k >> 2, m = k & 3;
#pragma unroll
            for (int bj = 0; bj < 2; ++bj)
#pragma unroll
                for (int n = 0; n < 2; ++n) *(f32x4*)(yb + (size_t)(ai * 128 + m * 16) * DM * 4 + voff + (bj * 128 + 4 * n) * 4) = xa[k % 3][bj][n] + gg[bj][n] * (acc[ai][bj][m][n] * rstd[ai][m]);
            if (k + 3 < 8) { const int k2 = k + 3, ai2 = k2 >> 2, m2 = k2 & 3;
#pragma unroll
                for (int bj = 0; bj < 2; ++bj)
#pragma unroll
                    for (int n = 0; n < 2; ++n) xa[k % 3][bj][n] = *(const f32x4*)(xb + (size_t)(ai2 * 128 + m2 * 16) * DM * 4 + voff + (bj * 128 + 4 * n) * 4); }
        }
    }
};

__device__ __forceinline__ f32x4 small_gemm(const bf16_t* A, const bf16_t* Bt, int n0, int wave, int lane) {
    const int fr = lane & 15, fq = lane >> 4;
    const bf16x8* ap = (const bf16x8*)(A + (size_t)(wave * 16 + fr) * DM + 8 * fq);
    const bf16x8* bp = (const bf16x8*)(Bt + (size_t)(n0 + fr) * DM + 8 * fq);
    f32x4 acc = {0.f, 0.f, 0.f, 0.f};
#pragma unroll 16
    for (int ks = 0; ks < 32; ++ks) acc = __builtin_amdgcn_mfma_f32_16x16x32_bf16(bp[ks * 4], ap[ks * 4], acc, 0, 0, 0);
    return acc;
}
#ifdef TPROBE
__device__ unsigned long long tp_last, tp_acc;
#define TP_T0() do { asm volatile("s_waitcnt lgkmcnt(0)" ::: "memory"); tp_t = wall_clock64(); } while (0)
#define TP_MARK(k) do { asm volatile("s_waitcnt lgkmcnt(0)" ::: "memory"); __builtin_amdgcn_sched_barrier(0); const unsigned long long n_ = wall_clock64(); if (TPROBE == (k)) tp_sum += n_ - tp_t; tp_t = n_; } while (0)
#else
#define TP_T0() do {} while (0)
#define TP_MARK(k) do {} while (0)
#endif
#define MFMA32(a, b, c) __builtin_amdgcn_mfma_f32_32x32x16_bf16((a), (b), (c), 0, 0, 0)
__device__ __forceinline__ void attn_unit(const P& p, int b, int h, int ci, const LAS float* biasL, LAS unsigned char* wl, int lane, unsigned long long& tp_sum) {
    unsigned long long tp_t = 0; (void)tp_t;
    constexpr float LOG2E = 1.4426950408889634f;
    const int r = lane & 31, h2 = lane >> 5;
    const size_t rowbase = (size_t)b * T;
    bf16x8 qf[2][4];
#pragma unroll
    for (int qt = 0; qt < 2; ++qt)
#pragma unroll
        for (int ks = 0; ks < 4; ++ks) qf[qt][ks] = *(const bf16x8*)(p.ZB + zb_off(3, b, h, ci * 64 + qt * 32 + r) + 16 * ks + 8 * h2);
    f32x16 o[2][2];
#pragma unroll
    for (int dt = 0; dt < 2; ++dt)
#pragma unroll
        for (int qt = 0; qt < 2; ++qt)
#pragma unroll
            for (int i = 0; i < 16; ++i) o[dt][qt][i] = 0.f;
    float m_used[2] = {-1e30f, -1e30f}, lsum[2] = {0.f, 0.f};
    const int cj0 = ci > 8 ? ci - 8 : 0, nblk = (ci - cj0 + 1) * 2, key_start = cj0 * 64;
    const int krow = lane >> 3, kch = lane & 7, vrow = lane >> 2, vch = lane & 3;
    const char* kg = (const char*)(p.ZB + zb_off(4, b, h, key_start));
    const char* vg = (const char*)(p.VT + (((size_t)(b * 8 + h)) * 256 + cj0) * 4096);
    const unsigned koff = (unsigned)(krow * 64 + 8 * kch) * 2u, voff = (unsigned)(vrow * 64 + 8 * vch) * 2u;
    LAS unsigned char* Ks = wl; LAS unsigned char* Vs = wl + 4608;
    LAS unsigned char* kw = Ks + krow * 144 + kch * 16; LAS unsigned char* vw = Vs + vrow * 72 + vch * 16;
    const LAS unsigned char* kr = Ks + r * 144 + h2 * 16; const LAS unsigned char* vr = Vs + r * 72 + h2 * 8;
    u32x4 sk[4], sv[4];
#pragma unroll
    for (int i = 0; i < 4; ++i) { sk[i] = *(const u32x4*)(kg + i * 1024 + koff); sv[i] = *(const u32x4*)(vg + i * 2048 + voff); }
    for (int blk = 0; blk < nblk; ++blk) {
        TP_T0();
        const int key0 = key_start + blk * 32;
#pragma unroll
        for (int i = 0; i < 4; ++i) { *(LAS u32x4*)(kw + i * 8 * 144) = sk[i];
            u32x2 lo = {sv[i].x, sv[i].y}, hi = {sv[i].z, sv[i].w}; *(LAS u32x2*)(vw + i * 16 * 72) = lo; *(LAS u32x2*)(vw + i * 16 * 72 + 8) = hi; }
        { const int nb = blk + 1 < nblk ? blk + 1 : blk;
#pragma unroll
          for (int i = 0; i < 4; ++i) { sk[i] = *(const u32x4*)(kg + (size_t)nb * 4096 + i * 1024 + koff); sv[i] = *(const u32x4*)(vg + (size_t)(nb >> 1) * 8192 + (nb & 1) * 64 + i * 2048 + voff); } }
        bf16x8 kf[4];
#pragma unroll
        for (int ks = 0; ks < 4; ++ks) kf[ks] = *(const LAS bf16x8*)(kr + ks * 32);
        TP_MARK(1);
        const bool far = key0 + 31 + 128 <= ci * 64;
        const float bcst = far ? biasL[256] : 0.f;
#pragma unroll
        for (int qt = 0; qt < 2; ++qt) {
            bf16x8 pf[2];
            f32x16 s;
#pragma unroll
            for (int i = 0; i < 16; ++i) s[i] = 0.f;
#pragma unroll
            for (int ks = 0; ks < 4; ++ks) s = MFMA32(kf[ks], qf[qt][ks], s);
            if (!far) {
#pragma unroll
                for (int i = 0; i < 16; ++i) { const int key = key0 + (i & 3) + 8 * (i >> 2) + 4 * h2; int dist = ci * 64 + qt * 32 + r - key; dist = dist < -128 ? -128 : (dist > 128 ? 128 : dist); s[i] += biasL[dist + 128]; }
            }
            float a = fmaxf(s[0], s[1]);
#pragma unroll
            for (int i = 2; i < 16; i += 2) a = fmaxf(a, fmaxf(s[i], s[i + 1]));
            const float mx = fmaxf(a, __shfl_xor(a, 32)) + bcst;
            if (__builtin_amdgcn_ballot_w64(mx > m_used[qt] + 8.f) != 0ull) {
                const float mnew = fmaxf(m_used[qt], mx), alpha = __builtin_amdgcn_exp2f((m_used[qt] - mnew) * LOG2E); lsum[qt] *= alpha; m_used[qt] = mnew;
#pragma unroll
                for (int dt = 0; dt < 2; ++dt)
#pragma unroll
                    for (int i = 0; i < 16; ++i) o[dt][qt][i] *= alpha;
            }
            const float cb = (bcst - m_used[qt]) * LOG2E;
#pragma unroll
            for (int i = 0; i < 16; ++i) { const float e = __builtin_amdgcn_exp2f(s[i] * LOG2E + cb); s[i] = e; lsum[qt] += e; }
#pragma unroll
            for (int sp = 0; sp < 2; ++sp) { u32x4 w; w.x = pkbf(s[8 * sp], s[8 * sp + 1]); w.y = pkbf(s[8 * sp + 2], s[8 * sp + 3]); w.z = pkbf(s[8 * sp + 4], s[8 * sp + 5]); w.w = pkbf(s[8 * sp + 6], s[8 * sp + 7]);
                pf[sp] = __builtin_bit_cast(bf16x8, w); }
            if (qt == 0) TP_MARK(2);
#pragma unroll
            for (int dt = 0; dt < 2; ++dt)
#pragma unroll
                for (int sp = 0; sp < 2; ++sp) { const u32x2 v0 = *(const LAS u32x2*)(vr + dt * 32 * 72 + sp * 32), v1 = *(const LAS u32x2*)(vr + dt * 32 * 72 + sp * 32 + 16);
                    u32x4 w; w.x = v0.x; w.y = v0.y; w.z = v1.x; w.w = v1.y; const bf16x8 vf = __builtin_bit_cast(bf16x8, w);
                    o[dt][qt] = MFMA32(vf, pf[sp], o[dt][qt]); }
        }
        TP_MARK(3);
    }
#pragma unroll
    for (int qt = 0; qt < 2; ++qt) { const float l = lsum[qt] + __shfl_xor(lsum[qt], 32), inv = 1.f / l;
#pragma unroll
        for (int dt = 0; dt < 2; ++dt)
#pragma unroll
            for (int g4 = 0; g4 < 4; ++g4) { const f32x4 v = {o[dt][qt][4 * g4] * inv, o[dt][qt][4 * g4 + 1] * inv, o[dt][qt][4 * g4 + 2] * inv, o[dt][qt][4 * g4 + 3] * inv};
                *(LAS f32x4*)(wl + r * 272 + (32 * dt + 8 * g4 + 4 * h2) * 4) = v; }
        const int er = lane >> 4, ec = (lane & 15) * 4;
#pragma unroll
        for (int i = 0; i < 8; ++i) { const int q = er + 4 * i; const f32x4 v = *(const LAS f32x4*)(wl + q * 272 + ec * 4); const size_t row = rowbase + ci * 64 + qt * 32 + q;
            const u32x2 gb = *(const u32x2*)(p.ZB + zb_off(6, b, h, ci * 64 + qt * 32 + q) + ec);
            u32x2 w; w.x = pkbf(v.x * bflo(gb.x), v.y * bfhi(gb.x)); w.y = pkbf(v.z * bflo(gb.y), v.w * bfhi(gb.y));
            *(u32x2*)(p.XN + row * DM + 512 + h * 64 + ec) = w; }
    }
}

__device__ __forceinline__ void gmlp_unit(const P& p, int b, int n, int g, LAS float* scr, int lane) {
    const int r = lane & 31, h2 = lane >> 5;
    const size_t rowbase = (size_t)b * T + n * 128;
    const bf16_t* abase = p.GVT + (((size_t)(b * 128 + n)) * 512 + g * 64 + r) * 128 + 8 * h2;
    const bf16_t* wbase = p.WST + ((size_t)(g * 128 + r)) * 128 + 8 * h2;
    f32x4 sa[2][4]; u32x4 raw[2][8]; bf16x8 wf[8];
#pragma unroll
    for (int e = 0; e < 2; ++e) { const f32x4* sp = (const f32x4*)(p.STATS + (rowbase + lane + 64 * e) * 16);
#pragma unroll
        for (int i = 0; i < 4; ++i) sa[e][i] = sp[i]; }
#pragma unroll
    for (int dt = 0; dt < 2; ++dt)
#pragma unroll
        for (int ks = 0; ks < 8; ++ks) raw[dt][ks] = *(const u32x4*)(abase + dt * 32 * 128 + 16 * ks);
#pragma unroll
    for (int ks = 0; ks < 2; ++ks) wf[ks] = *(const bf16x8*)(wbase + 16 * ks);
    float lg[2], lb[2];
#pragma unroll
    for (int dt = 0; dt < 2; ++dt) { lg[dt] = p.ln_g[g * 64 + 32 * dt + r]; lb[dt] = p.ln_b[g * 64 + 32 * dt + r]; }
#pragma unroll
    for (int e = 0; e < 2; ++e) { const int tl = lane + 64 * e; const f32x4 a0 = sa[e][0], a1 = sa[e][1], a2 = sa[e][2], a3 = sa[e][3];
        const float s1 = ((a0.x + a0.z) + (a1.x + a1.z)) + ((a2.x + a2.z) + (a3.x + a3.z)), s2 = ((a0.y + a0.w) + (a1.y + a1.w)) + ((a2.y + a2.w) + (a3.y + a3.w));
        const float mean = s1 * (1.f / 512.f), var = fmaxf(s2 * (1.f / 512.f) - mean * mean, 0.f), rstd = rsqrtf(var + EPS);
        f32x2_t sv = {rstd, -mean * rstd}; *(LAS f32x2_t*)(scr + tl * 2) = sv; }
    bf16x8 af[2][8];
#pragma unroll
    for (int ks = 0; ks < 8; ++ks) {
        f32x4 st[4];
#pragma unroll
        for (int i = 0; i < 4; ++i) st[i] = *(const LAS f32x4*)(scr + (16 * ks + 8 * h2) * 2 + 4 * i);
#pragma unroll
        for (int dt = 0; dt < 2; ++dt) { u32x4 w;
#pragma unroll
            for (int i = 0; i < 4; ++i) { const float x0 = bflo(raw[dt][ks][i]), x1 = bfhi(raw[dt][ks][i]);
                const float y0 = x0 * (st[i].x * lg[dt]) + (st[i].y * lg[dt] + lb[dt]), y1 = x1 * (st[i].z * lg[dt]) + (st[i].w * lg[dt] + lb[dt]); w[i] = pkbf(y0, y1); }
            af[dt][ks] = __builtin_bit_cast(bf16x8, w); }
    }
    LAS unsigned char* wl = (LAS unsigned char*)scr;
    const int er = lane >> 4, ec = (lane & 15) * 4;
#pragma unroll
    for (int tt = 0; tt < 4; ++tt) {
        bf16x8 wn[8];
        if (tt < 3) {
#pragma unroll
            for (int ks = 0; ks < 2 * tt + 4; ++ks) wn[ks] = *(const bf16x8*)(wbase + (size_t)((tt + 1) * 32) * 128 + 16 * ks); }
        u32x2 uu[8];
#pragma unroll
        for (int i = 0; i < 8; ++i) { const int t = n * 128 + 32 * tt + er + 4 * i; uu[i] = *(const u32x2*)(p.ZB + zb_off(0, b, g, t) + ec); }
        const float bs = p.b_s[g * 128 + 32 * tt + r];
        f32x16 acc[2];
#pragma unroll
        for (int dt = 0; dt < 2; ++dt)
#pragma unroll
            for (int i = 0; i < 16; ++i) acc[dt][i] = 0.f;
#pragma unroll
        for (int ks = 0; ks < 2 * tt + 2; ++ks)
#pragma unroll
            for (int dt = 0; dt < 2; ++dt) acc[dt] = MFMA32(af[dt][ks], wf[ks], acc[dt]);
#pragma unroll
        for (int dt = 0; dt < 2; ++dt)
#pragma unroll
            for (int g4 = 0; g4 < 4; ++g4) { const f32x4 v = {acc[dt][4 * g4] + bs, acc[dt][4 * g4 + 1] + bs, acc[dt][4 * g4 + 2] + bs, acc[dt][4 * g4 + 3] + bs};
                *(LAS f32x4*)(wl + r * 272 + (32 * dt + 8 * g4 + 4 * h2) * 4) = v; }
#pragma unroll
        for (int i = 0; i < 8; ++i) { const int tl = er + 4 * i; const f32x4 v = *(const LAS f32x4*)(wl + tl * 272 + ec * 4); const size_t row = rowbase + 32 * tt + tl;
            u32x2 w; w.x = pkbf(bflo(uu[i].x) * v.x, bfhi(uu[i].x) * v.y); w.y = pkbf(bflo(uu[i].y) * v.z, bfhi(uu[i].y) * v.w);
            *(u32x2*)(p.XN + row * DM + g * 64 + ec) = w; }
        if (tt < 3) {
#pragma unroll
            for (int ks = 0; ks < 2 * tt + 4; ++ks) wf[ks] = wn[ks]; }
    }
}

__device__ __forceinline__ void sgmlp_unit(const P& p, int b, int g, int lane) {
    const int c = g * 64 + lane; const float lgc = p.ln_g[c], lbc = p.ln_b[c];
    float vn[16];
#pragma unroll
    for (int s = 0; s < 16; ++s) { const int row = b * 16 + s; const float* zr = p.ZS + (size_t)row * DIN + SEG_V;
        const f32x4 a = *(const f32x4*)(zr + 4 * lane), bq = *(const f32x4*)(zr + 256 + 4 * lane);
        const float mean = wave_sum((a.x + a.y) + (a.z + a.w) + (bq.x + bq.y) + (bq.z + bq.w)) * (1.f / 512.f);
        const f32x4 da = a - mean, db = bq - mean;
        const float var = wave_sum((da.x * da.x + da.y * da.y) + (da.z * da.z + da.w * da.w) + (db.x * db.x + db.y * db.y) + (db.z * db.z + db.w * db.w)) * (1.f / 512.f);
        vn[s] = (zr[c] - mean) * rsqrtf(var + EPS) * lgc + lbc;
        p.out[OUT_GV + (size_t)row * 512 + c] = vn[s]; }
#pragma unroll
    for (int t = 0; t < 16; ++t) { float acc = 0.f;
#pragma unroll
        for (int s = 0; s <= t; ++s) acc += p.w_s[(size_t)g * 16384 + t * 128 + s] * vn[s];
        const int row = b * 16 + t; const float* zr = p.ZS + (size_t)row * DIN;
        const float y = zr[SEG_U + c] * (acc + p.b_s[g * 128 + t]) * zr[SEG_G + c];
        p.XN[(size_t)(MP + row) * DM + c] = (bf16_t)f2bf(y); }
}
__device__ __forceinline__ void sattn_block(const P& p, int b, int t, LAS float* part, const LAS float* biasL, int wave, int lane) {
    const int head = lane >> 3, sub = lane & 7, row = b * 16 + t, hoff = head * 64 + 8 * sub;
    const float* zq = p.ZS + (size_t)row * DIN + SEG_Q + hoff;
    const f32x4 q0 = *(const f32x4*)zq, q1 = *(const f32x4*)(zq + 4);
    float m = -1e30f, l = 0.f; f32x4 a0 = {0.f, 0.f, 0.f, 0.f}, a1 = {0.f, 0.f, 0.f, 0.f};
    const LAS float* bh = biasL + head * 257;
    const float* kc = p.cache_k + ((size_t)(b * 512 + wave * 64)) * 512 + hoff; const float* vc = p.cache_v + ((size_t)(b * 512 + wave * 64)) * 512 + hoff;
    asm volatile("; SATTN_LOOP_BEGIN");
#pragma unroll 1
    for (int bt = 0; bt < 8; ++bt) {
        f32x4 k0[8], k1[8], v0[8], v1[8]; float s[8];
#pragma unroll
        for (int j = 0; j < 8; ++j) { const size_t o = (size_t)(bt * 8 + j) * 512; k0[j] = *(const f32x4*)(kc + o); k1[j] = *(const f32x4*)(kc + o + 4); v0[j] = *(const f32x4*)(vc + o); v1[j] = *(const f32x4*)(vc + o + 4); }
        float mx = -1e30f;
#pragma unroll
        for (int j = 0; j < 8; ++j) { const int kk = wave * 64 + bt * 8 + j;
            float a = ((q0.x * k0[j].x + q0.y * k0[j].y) + (q0.z * k0[j].z + q0.w * k0[j].w)) + ((q1.x * k1[j].x + q1.y * k1[j].y) + (q1.z * k1[j].z + q1.w * k1[j].w));
            a += __shfl_xor(a, 1); a += __shfl_xor(a, 2); a += __shfl_xor(a, 4);
            int dist = 512 + t - kk; dist = dist > 128 ? 128 : dist;
            s[j] = a + bh[dist + 128]; mx = fmaxf(mx, s[j]); }
        const float mnew = fmaxf(m, mx), alpha = __expf(m - mnew);
        l *= alpha; a0 = a0 * alpha; a1 = a1 * alpha; m = mnew;
#pragma unroll
        for (int j = 0; j < 8; ++j) { const float e = __expf(s[j] - m); l += e; a0 += v0[j] * e; a1 += v1[j] * e; }
    }
    asm volatile("; SATTN_LOOP_END");
    { f32x4 k0[2], k1[2], v0[2], v1[2]; float s[2];
#pragma unroll
        for (int j = 0; j < 2; ++j) { const float* zr = p.ZS + (size_t)(b * 16 + 2 * wave + j) * DIN + hoff; k0[j] = *(const f32x4*)(zr + SEG_K); k1[j] = *(const f32x4*)(zr + SEG_K + 4); v0[j] = *(const f32x4*)(zr + SEG_VV); v1[j] = *(const f32x4*)(zr + SEG_VV + 4); }
#pragma unroll
        for (int j = 0; j < 2; ++j) {
            float a = ((q0.x * k0[j].x + q0.y * k0[j].y) + (q0.z * k0[j].z + q0.w * k0[j].w)) + ((q1.x * k1[j].x + q1.y * k1[j].y) + (q1.z * k1[j].z + q1.w * k1[j].w));
            a += __shfl_xor(a, 1); a += __shfl_xor(a, 2); a += __shfl_xor(a, 4);
            s[j] = a + bh[t - (2 * wave + j) + 128]; }
        const float mnew = fmaxf(m, fmaxf(s[0], s[1])), alpha = __expf(m - mnew);
        l *= alpha; a0 = a0 * alpha; a1 = a1 * alpha; m = mnew;
#pragma unroll
        for (int j = 0; j < 2; ++j) { const float e = __expf(s[j] - m); l += e; a0 += v0[j] * e; a1 += v1[j] * e; }
    }
    LAS float* pp = part + (wave * 64 + lane) * 12;
    pp[0] = m; pp[1] = l; *(LAS f32x4*)(pp + 4) = a0; *(LAS f32x4*)(pp + 8) = a1;
    __syncthreads();
    if (wave == 0) { float M = -1e30f;
#pragma unroll
        for (int w = 0; w < 8; ++w) M = fmaxf(M, part[(w * 64 + lane) * 12]);
        float L = 0.f; f32x4 o0 = {0.f, 0.f, 0.f, 0.f}, o1 = {0.f, 0.f, 0.f, 0.f};
#pragma unroll
        for (int w = 0; w < 8; ++w) { const LAS float* q = part + (w * 64 + lane) * 12; const float f = __expf(q[0] - M); L += q[1] * f; o0 += *(const LAS f32x4*)(q + 4) * f; o1 += *(const LAS f32x4*)(q + 8) * f; }
        const float inv = 1.f / L; const float* gp = p.ZS + (size_t)row * DIN + SEG_GB + hoff; const f32x4 g0 = *(const f32x4*)gp, g1 = *(const f32x4*)(gp + 4);
        u32x4 w; w.x = pkbf(o0.x * inv * g0.x, o0.y * inv * g0.y); w.y = pkbf(o0.z * inv * g0.z, o0.w * inv * g0.w); w.z = pkbf(o1.x * inv * g1.x, o1.y * inv * g1.y); w.w = pkbf(o1.z * inv * g1.z, o1.w * inv * g1.w);
        *(u32x4*)(p.XN + (size_t)(MP + row) * DM + 512 + hoff) = w; }
    __syncthreads();
}

__device__ __forceinline__ void phase5(const P& p, int wave, int lane) {
    const int gw = blockIdx.x * 8 + wave, NGW = gridDim.x * 8;
    for (int ms = gw; ms < MS; ms += NGW) {
        const int b = 2 + (ms >> 4); const float* xrow = p.x_sample + (size_t)ms * DM; float* yrow = p.out + OUT_YS + (size_t)ms * DM;
        f32x4 ov[4]; float ss = 0.f;
#pragma unroll
        for (int j = 0; j < 2; ++j)
#pragma unroll
            for (int i = 0; i < 2; ++i) { ov[2 * j + i] = *(const f32x4*)(p.OS + (size_t)ms * DM + 8 * lane + 512 * j + 4 * i); const f32x4 w = ov[2 * j + i]; ss += (w.x * w.x + w.y * w.y) + (w.z * w.z + w.w * w.w); }
        const float rstd = rsqrtf(wave_sum(ss) * (1.f / DM) + EPS);
        const float* gate = p.MOD + b * 3072 + 2048;
#pragma unroll
        for (int j = 0; j < 2; ++j)
#pragma unroll
            for (int i = 0; i < 2; ++i) { const int c = 8 * lane + 512 * j + 4 * i;
                const f32x4 xv = *(const f32x4*)(xrow + c), gt = *(const f32x4*)(gate + c), gp = *(const f32x4*)(p.g_post + c);
                *(f32x4*)(yrow + c) = xv + gt * (ov[2 * j + i] * rstd * gp); }
    }
}
#define XB_TMO      128
#define XB_XCNT(j)  (256  + 64 * (j))
#define XB_XSUB(j)  (1280 + 64 * (j))
#define XB_XGEN(j)  (2304 + 64 * (j))
#define XB_TOP      3328
#define XB_TOPGEN   3392
#define XCD_BAR_WORDS 3456
#define XB_SPIN_CAP (1u << 18)

__device__ __forceinline__ unsigned xb_ld(unsigned* p)              { return __hip_atomic_load(p, __ATOMIC_RELAXED, __HIP_MEMORY_SCOPE_AGENT); }
__device__ __forceinline__ unsigned xb_add(unsigned* p, unsigned v) { return __hip_atomic_fetch_add(p, v, __ATOMIC_RELAXED, __HIP_MEMORY_SCOPE_AGENT); }
__device__ __forceinline__ unsigned xb_xcc_id() { return (unsigned)__builtin_amdgcn_s_getreg((3 << 11) | 20) & 0xFu; }
#define XB_SPIN(cond, bar) do { unsigned _sp = 0; while (cond) { __builtin_amdgcn_s_sleep(1); \
    if ((++_sp & 255u) == 0u) { if (xb_ld(&(bar)[XB_TMO])) break; if (_sp > XB_SPIN_CAP) { atomicAdd(&(bar)[XB_TMO], 1u); break; } } } } while (0)

struct XcdBarrier {
    unsigned* bar; unsigned x;
    volatile LAS unsigned* st;
};

__device__ __forceinline__ XcdBarrier xcd_barrier_post(unsigned* bar, volatile LAS unsigned* st) {
    XcdBarrier b; b.bar = bar; b.x = xb_xcc_id(); b.st = st;
    if (threadIdx.x == 0) (void)xb_add(&bar[XB_XCNT(b.x)], 1u);
    return b;
}
__device__ __forceinline__ void xcd_barrier_complete(unsigned* bar, unsigned x, unsigned& nloc, unsigned& nx) {
    const unsigned G = gridDim.x * gridDim.y * gridDim.z;
    unsigned sum, cnt, mine, sp = 0u;
    for (;;) {
        sum = 0u; cnt = 0u; mine = 0u;
#pragma unroll
        for (unsigned j = 0; j < 16; ++j) { const unsigned c = xb_ld(&bar[XB_XCNT(j)]); sum += c; cnt += (c > 0u) ? 1u : 0u; mine = (j == x) ? c : mine; }
        if (sum == G) break;
        __builtin_amdgcn_s_sleep(1);
        if ((++sp & 255u) == 0u) { if (xb_ld(&bar[XB_TMO])) break; if (sp > XB_SPIN_CAP) { atomicAdd(&bar[XB_TMO], 1u); break; } }
    }
    nloc = mine > 0u ? mine : 1u; nx = cnt > 0u ? cnt : 1u;
}

__device__ __forceinline__ void xcd_barrier(const XcdBarrier& b) {
    asm volatile("s_waitcnt vmcnt(0)" ::: "memory");
    __syncthreads();
    if (threadIdx.x == 0) {
        unsigned* bar = b.bar;
        __builtin_amdgcn_s_waitcnt(0);
        unsigned nloc = b.st[0], nx = b.st[1];
        if (nloc == 0u) { xcd_barrier_complete(bar, b.x, nloc, nx); b.st[0] = nloc; b.st[1] = nx; }
        const unsigned old = xb_add(&bar[XB_XSUB(b.x)], 1u);
        const unsigned gen = old / nloc;
        if (old + 1u == (gen + 1u) * nloc) {
            __builtin_amdgcn_fence(__ATOMIC_RELEASE, "agent");
            asm volatile("s_waitcnt vmcnt(0)" ::: "memory");
            const unsigned og = xb_add(&bar[XB_TOP], 1u);
            const unsigned tg = og / nx;
            if (og + 1u == (tg + 1u) * nx) xb_add(&bar[XB_TOPGEN], 1u);
            else XB_SPIN(xb_ld(&bar[XB_TOPGEN]) == tg, bar);
            __builtin_amdgcn_fence(__ATOMIC_ACQUIRE, "agent");
            xb_add(&bar[XB_XGEN(b.x)], 1u);
            asm volatile("s_waitcnt vmcnt(0)" ::: "memory");
        } else {
            XB_SPIN(xb_ld(&bar[XB_XGEN(b.x)]) == gen, bar);
            __builtin_amdgcn_fence(__ATOMIC_ACQUIRE, "agent");
            asm volatile("s_waitcnt vmcnt(0)" ::: "memory");
        }
    }
    __syncthreads();
}

#ifndef AT_REP
#define AT_REP 1
#endif
#ifndef GM_REP
#define GM_REP 1
#endif
__global__ void __launch_bounds__(512, 2) hymba_fwd(P p) {
    extern __shared__ __attribute__((aligned(16))) unsigned char lds_raw[];
    cg::grid_group grid = cg::this_grid();
    LAS unsigned char* lds = (LAS unsigned char*)lds_raw;
    int tid = threadIdx.x, lane = tid & 63, wave = __builtin_amdgcn_readfirstlane(tid >> 6);
#define FRESH() do { int t_ = threadIdx.x; asm volatile("" : "+v"(t_)); tid = t_; lane = t_ & 63; wave = __builtin_amdgcn_readfirstlane(t_ >> 6); } while (0)
    const int lo = p.ph_lo, hi = p.ph_hi;
    volatile LAS unsigned* bst = (volatile LAS unsigned*)(lds + LDS_BYTES - 64);
    if (threadIdx.x < 2) bst[threadIdx.x] = 0u;
    __syncthreads();
    XcdBarrier bar; bar.bar = p.BAR; bar.x = 0; bar.st = bst;
    if (hi - lo > 1) bar = xcd_barrier_post(p.BAR, bst);
    if (hi > 1000) grid.sync();
    unsigned long long tp_sum = 0; (void)tp_sum;
#ifdef TPROBE
    unsigned long long tq = wall_clock64();
#define TQ(k) do { const unsigned long long n_ = wall_clock64(); if (TPROBE == (k)) tp_sum += n_ - tq; tq = n_; } while (0)
#else
#define TQ(k) do {} while (0)
#endif
#define IN(k) (lo <= (k) && (k) < hi)
#define SEAM(k) do { if (IN(k) && IN((k) + 1)) xcd_barrier(bar); } while (0)
#ifndef NO_P0
    if (IN(0)) phase0(p, lds, tid, wave, lane);
#endif
    SEAM(0); TQ(20); FRESH();
#ifndef NO_P1
    if (IN(1)) { phase1(p, wave, lane); phase0b(p, lds, tid, wave, lane); }
#endif
    SEAM(1); TQ(21); FRESH();
#ifndef NO_P2
    if (IN(2)) {
        pg8::Gemm g{p.XN, p.WIN, MP, DIN, DM}; pg8::StaticOrder S; S.init(MP, DIN, (int)gridDim.x, (int)blockIdx.x);
        EpiIn E{p.ZB, p.GVT, p.VT, p.STATS, p.out + OUT_KP, p.out + OUT_VP};
        pg8::gemm_phase<EpiIn, pg8::StaticOrder, true, true>(lds, g, S, E);
        for (int un = blockIdx.x; un < DIN / 16; un += gridDim.x) {
            const int n0 = un * 16; const f32x4 a = small_gemm(p.XN + (size_t)MP * DM, p.WIN, n0, wave, lane);
            const int row = wave * 16 + (lane & 15), cp = n0 + 4 * (lane >> 4);
            const int c = cp < 1024 ? ((cp & 255) < 128 ? 128 * (cp >> 8) + (cp & 255) : 1024 + 128 * (cp >> 8) + (cp & 255) - 128) : (cp < 1536 ? cp - 512 : cp), seg = c >> 9; float v[4] = {a[0], a[1], a[2], a[3]};
            if (seg <= 1) {
#pragma unroll
                for (int i = 0; i < 4; ++i) v[i] = gelu_t(v[i]); }
            else if (seg == 2 || seg == 6) {
#pragma unroll
                for (int i = 0; i < 4; ++i) v[i] = silu_f(v[i]); }
            else if (seg == 3) {
#pragma unroll
                for (int i = 0; i < 4; ++i) v[i] *= 0.125f; }
            const f32x4 vv = {v[0], v[1], v[2], v[3]};
            *(f32x4*)(p.ZS + (size_t)row * DIN + c) = vv;
            if (seg == 4) *(f32x4*)(p.out + OUT_KS + (size_t)row * 512 + (c - SEG_K)) = vv;
            if (seg == 5) *(f32x4*)(p.out + OUT_VS + (size_t)row * 512 + (c - SEG_VV)) = vv;
        }
    }

#endif
    TQ(30); SEAM(2); TQ(22); FRESH();
    if (IN(3)) {
        LAS float* biasL = (LAS float*)lds;
        for (int i = tid; i < 8 * 257; i += 512) biasL[i] = p.rel_bias[i];
        __syncthreads();
        LAS unsigned char* wl = lds + 16384 + wave * 9216; LAS float* wscr = (LAS float*)wl;
        const int G_ = (int)gridDim.x, vcu = (G_ % 8 == 0) ? ((int)blockIdx.x % 8) * (G_ / 8) + (int)blockIdx.x / 8 : (int)blockIdx.x;
        const int gw = vcu * 8 + wave, NGW = G_ * 8;
        TQ(9);
        if (blockIdx.x < MS) sattn_block(p, (int)blockIdx.x & 7, (int)blockIdx.x >> 3, (LAS float*)(lds + 16384), biasL, wave, lane);
        TQ(11); FRESH();
        { const int xq = G_ % 8 == 0 ? (int)blockIdx.x % 8 : 0, nq = G_ % 8 == 0 ? 8 : 1;
          unsigned* ctr = p.QCTR + 64 * xq;
          const int n_sg = 64 / nq, n_at = 4096 / nq, n_gm = 2048 / nq, n_all = n_sg + n_at + n_gm;
          int nxt = 0; if (lane == 0) nxt = (int)atomicAdd(ctr, 1u); nxt = __builtin_amdgcn_readfirstlane(nxt);
          while (nxt < n_all) {
              const int it = nxt; FRESH();
              if (it < n_sg) { const int un = it * nq + xq; sgmlp_unit(p, un >> 3, un & 7, lane); }
              else if (it < n_sg + n_at) { const int j = it - n_sg, pair = (j >> 8) * nq + xq, ci = j & 255; attn_unit(p, pair >> 3, pair & 7, ci, biasL + (pair & 7) * 257, wl, lane, tp_sum); }
              else { const int un = (it - n_sg - n_at) * nq + xq, n = un & 127, g = (un >> 7) & 7, b = un >> 10; gmlp_unit(p, b, n, g, wscr, lane); }
              { int v = 0; if (lane == 0) v = (int)atomicAdd(ctr, 1u); nxt = __builtin_amdgcn_readfirstlane(v); }
          }
        }
        TQ(13);
    }

    TQ(31); SEAM(3); TQ(23); FRESH();
#ifndef NO_P4
    if (IN(4)) {
        pg8::Gemm g{p.XN, p.WOUT, MP, DM, DM}; pg8::StaticOrder S; S.init(MP, DM, (int)gridDim.x, (int)blockIdx.x);
        EpiOut E{p.x_prompt, p.out + OUT_YP, p.MOD, p.g_post, p.STATS, p.PCNT};
        pg8::gemm_phase<EpiOut, pg8::StaticOrder, true, true>(lds, g, S, E);
        for (int un = blockIdx.x; un < DM / 16; un += gridDim.x) {
            const int n0 = un * 16; const f32x4 a = small_gemm(p.XN + (size_t)MP * DM, p.WOUT, n0, wave, lane);
            *(f32x4*)(p.OS + (size_t)(wave * 16 + (lane & 15)) * DM + n0 + 4 * (lane >> 4)) = a;
        }
    }

#endif
    TQ(32); SEAM(4); TQ(24); FRESH();
#ifndef NO_P5
    if (IN(5)) phase5(p, wave, lane);
#endif
    TQ(25);
#ifdef TPROBE
    if (blockIdx.x == 8 && wave == 0) { const unsigned long long t0 = wall_clock64(); while (wall_clock64() - t0 < 4ull * tp_sum) __builtin_amdgcn_s_sleep(8); }
#endif
#undef IN
#undef SEAM
}

#ifndef N_LAUNCHES
#define N_LAUNCHES 1
#endif
extern "C" void kernel_launch(void* const* d_in, const int* in_sizes, int n_in, void* d_out, int out_size, void* d_ws, size_t ws_size, hipStream_t stream) {
    static int grid = 0;
    if (grid == 0) {
        if (n_in != 17 || ws_size < WS_END) { fprintf(stderr, "kernel_launch: unexpected n_in %d / ws %zu\n", n_in, ws_size); grid = -1; return; }
        int dev = 0, cus = 0, per_cu = 0;
        if (hipGetDevice(&dev) != hipSuccess || hipDeviceGetAttribute(&cus, hipDeviceAttributeMultiprocessorCount, dev) != hipSuccess) { grid = -1; return; }
        if (hipFuncSetAttribute((const void*)hymba_fwd, hipFuncAttributeMaxDynamicSharedMemorySize, LDS_BYTES) != hipSuccess) { fprintf(stderr, "kernel_launch: hipFuncSetAttribute failed\n"); grid = -1; return; }
        if (hipOccupancyMaxActiveBlocksPerMultiprocessor(&per_cu, (const void*)hymba_fwd, 512, LDS_BYTES) != hipSuccess || per_cu < 1) { fprintf(stderr, "kernel_launch: occupancy query says %d\n", per_cu); grid = -1; return; }
        grid = cus;
    }
    if (grid < 0) return;
    P p{};
    const float** in = (const float**)&p.x_prompt;
    for (int i = 0; i < 17; ++i) in[i] = (const float*)d_in[i];
    unsigned char* ws = (unsigned char*)d_ws;
    p.out = (float*)d_out;
    p.MOD = (float*)(ws + WS_MOD); p.WIN = (bf16_t*)(ws + WS_WIN); p.WOUT = (bf16_t*)(ws + WS_WOUT); p.WST = (bf16_t*)(ws + WS_WST); p.STATS = (float*)(ws + WS_STATS);
    p.XN = (bf16_t*)(ws + WS_XN); p.ZB = (bf16_t*)(ws + WS_ZB); p.GVT = (bf16_t*)(ws + WS_GVT); p.VT = (bf16_t*)(ws + WS_VT); p.OB = (bf16_t*)(ws + WS_OB);
    p.ZS = (float*)(ws + WS_ZS); p.OS = (float*)(ws + WS_OS); p.QCTR = (unsigned*)(ws + WS_QCTR); p.PCNT = (unsigned*)(ws + WS_PCNT); p.BAR = (unsigned*)(ws + WS_BAR);
    if (hipMemsetAsync(ws + WS_BAR, 0, 16384, stream) != hipSuccess) { fprintf(stderr, "kernel_launch: memset failed\n"); return; }
#if N_LAUNCHES == 1
    p.ph_lo = 0; p.ph_hi = 6;
    void* args[] = {&p};
    hipError_t e = hipLaunchCooperativeKernel((const void*)hymba_fwd, dim3(grid), dim3(512), args, LDS_BYTES, stream);
    if (e != hipSuccess) fprintf(stderr, "kernel_launch: cooperative launch failed: %s (grid %d)\n", hipGetErrorString(e), grid);
#else
#ifndef PROBE_REP
#define PROBE_REP -1
#endif
    for (int ph = 0; ph < 6; ++ph) { p.ph_lo = ph; p.ph_hi = ph + 1;
        for (int rep = 0; rep < (ph == PROBE_REP ? 2 : 1); ++rep) hipLaunchKernelGGL(hymba_fwd, dim3(grid), dim3(512), LDS_BYTES, stream, p); }
#endif
}
```

```cpp
#include <hip/hip_runtime.h>
#include <hip/hip_cooperative_groups.h>
#include <cstdio>
#include <cstdint>
namespace cg = cooperative_groups;
namespace pg8 {
#define PG8_LAS __attribute__((address_space(3)))
typedef unsigned short bf16_t;
typedef short bf16x8 __attribute__((ext_vector_type(8)));
typedef float f32x4 __attribute__((ext_vector_type(4)));
typedef unsigned u32x4 __attribute__((ext_vector_type(4)));
constexpr int BM = 256, BK = 64, HALF = 128, HTB = HALF * BK * 2  , STAGE_BYTES = 8 * HTB, NXCD = 8, WGM = 8;

__host__ __device__ __forceinline__ int lds_byte(int r, int c) { const int st = (r >> 4) * 2 + (c >> 5), rr = r & 15, cc = c & 31, ob = rr * 64 + cc * 2; return st * 1024 + (ob ^ (((ob >> 9) & 1) << 5)); }
__host__ __device__ __forceinline__ void stage_rc(int b, int& R, int& C) { const int st = b / 1024, sb = b % 1024, swz = sb ^ (((sb >> 9) & 1) << 5); R = (st >> 1) * 16 + swz / 64; C = (st & 1) * 32 + (swz % 64) / 2; }
__host__ __device__ __forceinline__ int perm32(int rho) { const int n = rho >> 4, i = rho & 15; return 8 * (i >> 2) + 4 * n + (i & 3); }

struct Unit { int pm, pn; };
struct Gemm { const bf16_t* A; const bf16_t* Bt; int M, N, K; };

struct StaticOrder {
    int nM, nN, nwg, G, c;
    __host__ __device__ void init(int M, int N, int G_, int c_) { nM = M / BM; nN = N / BM; nwg = nM * nN; G = G_; c = c_; }
    __host__ __device__ bool next(int i, Unit& u) const {
        const long L = (long)i * G + c; if (L >= nwg) return false;
        int wgid = (int)L; { const int q = nwg / NXCD, r = nwg % NXCD, xcd = wgid % NXCD, off = wgid / NXCD; wgid = (xcd < r ? xcd * (q + 1) : r * (q + 1) + (xcd - r) * q) + off; }
        const int nig = WGM * nN, gid = wgid / nig, fm = gid * WGM, gsz = (nM - fm) < WGM ? (nM - fm) : WGM;
        u.pm = fm + ((wgid % nig) % gsz); u.pn = (wgid % nig) / gsz; return true;
    }
    __device__ __forceinline__ void a_ready(const Unit&) const {}
    __device__ __forceinline__ void done(const Unit&) const {}
};

__device__ __forceinline__ unsigned cvt_pk_bf16(float lo, float hi) { unsigned r; asm volatile("v_cvt_pk_bf16_f32 %0, %1, %2" : "=v"(r) : "v"(lo), "v"(hi)); return r; }
typedef float f32x2 __attribute__((ext_vector_type(2)));
template <class Epi, class Sched, bool ALIGN_EPI = false, bool SP2 = false>
__device__ __forceinline__ void gemm_phase(PG8_LAS unsigned char* lds, const Gemm g, const Sched& S, const Epi& E) {
    const int tid = threadIdx.x, wid = __builtin_amdgcn_readfirstlane(tid >> 6), lane = tid & 63, wr = wid >> 2, wc = wid & 3, fr = lane & 15, fq = lane >> 4;
    const int K = g.K, nt = K / BK;
    unsigned voffA[2], voffB[2];
#pragma unroll
    for (int i = 0; i < 2; ++i) { int R, C; stage_rc(tid * 16 + i * 8192, R, C); const int Rb = Epi::PERM ? ((R & ~31) + perm32(R & 31)) : R;
        voffA[i] = (unsigned)(R * K + C) * 2u; voffB[i] = (unsigned)(Rb * K + C) * 2u; }
    const size_t kstep = (size_t)(BK * 2);
    const size_t hstep = (size_t)HALF * K * 2;
    const size_t tstep = 2 * hstep;
    const unsigned ldsw = (unsigned)wid * 1024u;
    const int aoff = lds_byte(wr * 64 + fr, fq * 8), boff = lds_byte(wc * 32 + fr, fq * 8);
#define PG8_SA(b, h) (((b) * 2 + (h)) * HTB)
#define PG8_SB(b, h) ((4 + (b) * 2 + (h)) * HTB)
#define PG8_STAGE(bufoff, gbase, voff) do { _Pragma("unroll") for (int _i = 0; _i < 2; ++_i) \
        __builtin_amdgcn_global_load_lds((const unsigned*)((const char*)(gbase) + (voff)[_i]), (PG8_LAS unsigned*)(lds + (bufoff) + ldsw + _i * 8192), 16, 0, 0); } while (0)
#define PG8_LDA(dst, b, h) do { _Pragma("unroll") for (int m = 0; m < 4; ++m) _Pragma("unroll") for (int k = 0; k < 2; ++k) dst[m][k] = *(const PG8_LAS bf16x8*)(lds + PG8_SA(b, h) + aoff + m * 2048 + k * 1024); } while (0)
#define PG8_LDB(dst, b, h) do { _Pragma("unroll") for (int n = 0; n < 2; ++n) _Pragma("unroll") for (int k = 0; k < 2; ++k) dst[n][k] = *(const PG8_LAS bf16x8*)(lds + PG8_SB(b, h) + boff + n * 2048 + k * 1024); } while (0)
#define PG8_MMA(ai, bj, At, Bt) do { __builtin_amdgcn_s_setprio(1); _Pragma("unroll") for (int m = 0; m < 4; ++m) _Pragma("unroll") for (int n = 0; n < 2; ++n) _Pragma("unroll") for (int k = 0; k < 2; ++k) \
        acc[ai][bj][m][n] = __builtin_amdgcn_mfma_f32_16x16x32_bf16(Bt[n][k], At[m][k], acc[ai][bj][m][n], 0, 0, 0); __builtin_amdgcn_s_setprio(0); } while (0)
#define PG8_WAIT_V(n) asm volatile("s_waitcnt vmcnt(" #n ")" ::: "memory")
#define PG8_WAIT_L(n) asm volatile("s_waitcnt lgkmcnt(" #n ")" ::: "memory")
#define PG8_BAR __builtin_amdgcn_s_barrier()
#define PG8_SCHED __builtin_amdgcn_sched_barrier(0)
    Unit cur, nxt; int ui = 0;
    if (!S.next(0, cur)) return;
    f32x4 acc[2][2][4][2];
#pragma unroll
    for (int a = 0; a < 2; ++a)
#pragma unroll
        for (int b = 0; b < 2; ++b)
#pragma unroll
            for (int m = 0; m < 4; ++m)
#pragma unroll
                for (int n = 0; n < 2; ++n) acc[a][b][m][n] = (f32x4){0.f, 0.f, 0.f, 0.f};
    bf16x8 At[4][2], B0[2][2], B1[2][2];
    const char* cA = (const char*)g.A + (size_t)cur.pm * tstep; const char* cB = (const char*)g.Bt + (size_t)cur.pn * tstep;
    S.a_ready(cur);
    if constexpr (SP2) {
        PG8_STAGE(PG8_SB(0, 0), cB, voffB); PG8_STAGE(PG8_SB(0, 1), cB + hstep, voffB); PG8_STAGE(PG8_SA(0, 0), cA, voffA); PG8_STAGE(PG8_SA(0, 1), cA + hstep, voffA);
        if (wr == 1) PG8_BAR;
        PG8_WAIT_V(2); PG8_BAR;
        PG8_STAGE(PG8_SB(1, 0), cB + kstep, voffB); PG8_STAGE(PG8_SA(1, 0), cA + kstep, voffA); PG8_STAGE(PG8_SB(1, 1), cB + hstep + kstep, voffB);
        PG8_WAIT_V(6); PG8_BAR;
    } else {
        PG8_STAGE(PG8_SB(0, 0), cB, voffB); PG8_STAGE(PG8_SA(0, 0), cA, voffA); PG8_STAGE(PG8_SB(0, 1), cB + hstep, voffB); PG8_STAGE(PG8_SA(0, 1), cA + hstep, voffA);
        if (wr == 1) PG8_BAR;
        PG8_WAIT_V(4); PG8_BAR;
        PG8_STAGE(PG8_SB(1, 0), cB + kstep, voffB); PG8_STAGE(PG8_SA(1, 0), cA + kstep, voffA); PG8_STAGE(PG8_SB(1, 1), cB + hstep + kstep, voffB);
        PG8_WAIT_V(6); PG8_BAR;
    }
    for (;;) {
        const bool has_next = S.next(ui + 1, nxt);
        const char* nA = has_next ? (const char*)g.A + (size_t)nxt.pm * tstep : cA; const char* nB = has_next ? (const char*)g.Bt + (size_t)nxt.pn * tstep : cB;
        for (int t = 0; t < nt; t += 2) {
            const bool last = (t == nt - 2);
            const char* a1 = cA + (size_t)(t + 1) * kstep;
            const char* a2 = last ? nA : cA + (size_t)(t + 2) * kstep; const char* b2 = last ? nB : cB + (size_t)(t + 2) * kstep;
            const char* a3 = a2 + kstep; const char* b3 = b2 + kstep;
            if (last && has_next) S.a_ready(nxt);
            if constexpr (SP2) {
            PG8_LDB(B0, 0, 0); PG8_LDB(B1, 0, 1); PG8_SCHED; PG8_LDA(At, 0, 0); PG8_STAGE(PG8_SA(1, 1), a1 + hstep, voffA);
            PG8_WAIT_V(8); PG8_WAIT_L(0); PG8_BAR; PG8_MMA(0, 0, At, B0); PG8_MMA(0, 1, At, B1); PG8_BAR; PG8_SCHED;
            PG8_LDA(At, 0, 1); PG8_STAGE(PG8_SB(0, 0), b2, voffB); PG8_STAGE(PG8_SB(0, 1), b2 + hstep, voffB); PG8_STAGE(PG8_SA(0, 0), a2, voffA);
            PG8_WAIT_V(8); PG8_WAIT_L(0); PG8_BAR; PG8_MMA(1, 0, At, B0); PG8_MMA(1, 1, At, B1); PG8_BAR; PG8_SCHED;
            PG8_LDB(B0, 1, 0); PG8_LDB(B1, 1, 1); PG8_SCHED; PG8_LDA(At, 1, 0); PG8_STAGE(PG8_SA(0, 1), a2 + hstep, voffA);
            PG8_WAIT_V(8); PG8_WAIT_L(0); PG8_BAR; PG8_MMA(0, 0, At, B0); PG8_MMA(0, 1, At, B1); PG8_BAR; PG8_SCHED;
            PG8_LDA(At, 1, 1); PG8_STAGE(PG8_SB(1, 0), b3, voffB); PG8_STAGE(PG8_SB(1, 1), b3 + hstep, voffB); PG8_STAGE(PG8_SA(1, 0), a3, voffA);
            PG8_WAIT_V(8); PG8_WAIT_L(0); PG8_BAR; PG8_MMA(1, 0, At, B0); PG8_MMA(1, 1, At, B1); PG8_BAR; PG8_SCHED;
            } else {
            PG8_LDB(B0, 0, 0); PG8_SCHED; PG8_LDA(At, 0, 0); PG8_STAGE(PG8_SA(1, 1), a1 + hstep, voffA);
            PG8_WAIT_L(8); PG8_BAR; PG8_WAIT_L(0); PG8_MMA(0, 0, At, B0); PG8_BAR; PG8_SCHED;
            PG8_LDB(B1, 0, 1); PG8_STAGE(PG8_SB(0, 0), b2, voffB);
            PG8_BAR; PG8_WAIT_L(0); PG8_MMA(0, 1, At, B1); PG8_BAR;
            PG8_LDA(At, 0, 1); PG8_STAGE(PG8_SA(0, 0), a2, voffA);
            PG8_BAR; PG8_WAIT_L(0); PG8_MMA(1, 0, At, B0); PG8_BAR; PG8_SCHED;
            PG8_STAGE(PG8_SB(0, 1), b2 + hstep, voffB);
            PG8_WAIT_V(6); PG8_BAR; PG8_MMA(1, 1, At, B1); PG8_BAR;
            PG8_LDB(B0, 1, 0); PG8_SCHED; PG8_LDA(At, 1, 0); PG8_STAGE(PG8_SA(0, 1), a2 + hstep, voffA);
            PG8_WAIT_L(8); PG8_BAR; PG8_WAIT_L(0); PG8_MMA(0, 0, At, B0); PG8_BAR; PG8_SCHED;
            PG8_LDB(B1, 1, 1); PG8_STAGE(PG8_SB(1, 0), b3, voffB);
            PG8_BAR; PG8_WAIT_L(0); PG8_MMA(0, 1, At, B1); PG8_BAR;
            PG8_LDA(At, 1, 1); PG8_STAGE(PG8_SA(1, 0), a3, voffA);
            PG8_BAR; PG8_WAIT_L(0); PG8_MMA(1, 0, At, B0); PG8_BAR; PG8_SCHED;
            PG8_STAGE(PG8_SB(1, 1), b3 + hstep, voffB);
            PG8_WAIT_V(6); PG8_BAR; PG8_MMA(1, 1, At, B1); PG8_BAR;
            }
        }
        if constexpr (ALIGN_EPI) { if (wr == 0) PG8_BAR; }
        if constexpr (!Epi::AFTER_DRAIN) { E(acc, cur, wr, wc, fr, fq); S.done(cur); }
        if (!has_next) break;
#pragma unroll
        for (int a = 0; a < 2; ++a)
#pragma unroll
            for (int b = 0; b < 2; ++b)
#pragma unroll
                for (int m = 0; m < 4; ++m)
#pragma unroll
                    for (int n = 0; n < 2; ++n) acc[a][b][m][n] = (f32x4){0.f, 0.f, 0.f, 0.f};
        cur = nxt; cA = nA; cB = nB; ++ui;
        if constexpr (ALIGN_EPI) { if (wr == 1) PG8_BAR; }
    }
    PG8_WAIT_V(0);
    if constexpr (!ALIGN_EPI) { if (wr == 0) PG8_BAR; }
    PG8_BAR;
    if constexpr (Epi::AFTER_DRAIN) { E.fused(acc, cur, wr, wc, fr, fq, lds, wid, lane); S.done(cur); }
#undef PG8_SA
#undef PG8_SB
#undef PG8_STAGE
#undef PG8_LDA
#undef PG8_LDB
#undef PG8_MMA
#undef PG8_WAIT_V
#undef PG8_WAIT_L
#undef PG8_BAR
#undef PG8_SCHED
}
}

using pg8::bf16_t; using pg8::bf16x8; using pg8::f32x4; using pg8::u32x4;
#define GAS __attribute__((address_space(1)))
#define LAS __attribute__((address_space(3)))
typedef unsigned v4u __attribute__((ext_vector_type(4)));
typedef unsigned u32x2 __attribute__((ext_vector_type(2)));
typedef float f32x16 __attribute__((ext_vector_type(16)));
typedef float f32x2_t __attribute__((ext_vector_type(2)));
typedef __bf16 bf16x2_t __attribute__((ext_vector_type(2)));
#define LDS_WAIT() asm volatile("s_waitcnt lgkmcnt(0)" ::: "memory")
__device__ __forceinline__ unsigned f2bf(float f) { unsigned u = __builtin_bit_cast(unsigned, f); return (u + 0x7fffu + ((u >> 16) & 1u)) >> 16; }
__device__ __forceinline__ unsigned pk2(float lo, float hi) { return f2bf(lo) | (f2bf(hi) << 16); }
__device__ __forceinline__ unsigned pkbf(float lo, float hi) { f32x2_t v = {lo, hi}; bf16x2_t b = __builtin_convertvector(v, bf16x2_t); return __builtin_bit_cast(unsigned, b); }
__device__ __forceinline__ float bflo(unsigned w) { return __uint_as_float(w << 16); }
__device__ __forceinline__ float bfhi(unsigned w) { return __uint_as_float(w & 0xffff0000u); }
__device__ __forceinline__ float wave_sum(float v) {
#pragma unroll
    for (int o = 1; o < 64; o <<= 1) v += __shfl_xor(v, o);
    return v;
}
__device__ __forceinline__ float wave_max(float v) {
#pragma unroll
    for (int o = 1; o < 64; o <<= 1) v = fmaxf(v, __shfl_xor(v, o));
    return v;
}
__device__ __forceinline__ float gelu_t(float x) {
    constexpr float K1 = -2.f * 0.7978845608028654f * 1.4426950408889634f, K2 = K1 * 0.044715f;
    return x * __builtin_amdgcn_rcpf(1.f + __builtin_amdgcn_exp2f(x * (K1 + K2 * (x * x))));
}
__device__ __forceinline__ float silu_f(float x) { return x * __builtin_amdgcn_rcpf(1.f + __builtin_amdgcn_exp2f(x * -1.4426950408889634f)); }

constexpr int DM = 1024, T = 16384, NB = 2, MP = NB * T, SBT = 8, STT = 16, MS = SBT * STT, DIN = 3584;
constexpr int SEG_U = 0, SEG_V = 512, SEG_G = 1024, SEG_Q = 1536, SEG_K = 2048, SEG_VV = 2560, SEG_GB = 3072;
constexpr float EPS = 1e-6f;
constexpr size_t OUT_YP = 0, OUT_YS = 33554432, OUT_KP = 33685504, OUT_VP = 34209792, OUT_KS = 34734080, OUT_VS = 34799616, OUT_GV = 34865152;
constexpr size_t MiB = 1u << 20;
constexpr size_t WS_MOD = 0, WS_QCTR = 512 * 1024, WS_PCNT = 640 * 1024, WS_BAR = 768 * 1024, WS_WIN = 1 * MiB, WS_WOUT = 8 * MiB, WS_WST = 10 * MiB, WS_STATS = 11 * MiB, WS_XN = 16 * MiB, WS_ZB = 96 * MiB,
                 WS_GVT = 320 * MiB, WS_VT = 352 * MiB, WS_OB = 384 * MiB, WS_ZS = 448 * MiB, WS_OS = 450 * MiB, WS_END = 451 * MiB;
constexpr int LDS_BYTES = 147456;
__device__ __forceinline__ size_t zb_off(int seg, int b, int hg, int t) { return ((((size_t)seg * 2 + b) * 8 + hg) * T + t) * 64; }

struct P {
    const float *x_prompt, *x_sample, *cache_k, *cache_v, *c_prompt, *c_sample, *g_pre, *w_ada, *b_ada, *w_in, *ln_g, *ln_b, *w_s, *b_s, *rel_bias, *w_out, *g_post;
    float* out;
    float* MOD; bf16_t* WIN; bf16_t* WOUT; bf16_t* WST; float* STATS; bf16_t* XN; bf16_t* ZB; bf16_t* GVT; bf16_t* VT; bf16_t* OB; float* ZS; float* OS; unsigned* QCTR; unsigned* PCNT; unsigned* BAR;
    int ph_lo, ph_hi;
};
__device__ __forceinline__ void p0_transpose_item(const float* W, int K, int N, bf16_t* WT, int row_off, LAS float* scr, int item, int lane) {
    const int nblk = N / 32, kb = item / nblk, nb = item % nblk, k0 = 64 * kb, n0 = 32 * nb;
#pragma unroll
    for (int i = 0; i < 32; ++i) { const int kk = 2 * i + (lane >> 5); scr[kk * 33 + (lane & 31)] = W[(size_t)(k0 + kk) * N + n0 + (lane & 31)]; }
    LDS_WAIT(); asm volatile("" ::: "memory");
    const int c = lane & 7;
#pragma unroll
    for (int j = 0; j < 4; ++j) { const int n = (lane >> 3) + 8 * j; const LAS float* s = scr + (8 * c) * 33 + n;
        v4u o; o.x = pk2(s[0 * 33], s[1 * 33]); o.y = pk2(s[2 * 33], s[3 * 33]); o.z = pk2(s[4 * 33], s[5 * 33]); o.w = pk2(s[6 * 33], s[7 * 33]);
        *(GAS v4u*)(WT + (size_t)(row_off + n0 + n) * K + k0 + 8 * c) = o; }
    LDS_WAIT(); asm volatile("" ::: "memory");
}
__device__ __forceinline__ void phase0(const P& p, LAS unsigned char* lds, int tid, int wave, int lane) {
    if (blockIdx.x < 192) {
        LAS float* sc = (LAS float*)lds;
        LAS float* red = sc + 10240;
        const int j0 = blockIdx.x * 16, j = lane & 15, ks = lane >> 4;
        float wv[32];
#pragma unroll
        for (int i = 0; i < 32; ++i) wv[i] = p.w_ada[(size_t)(wave * 128 + i * 4 + ks) * 3072 + j0 + j];
#pragma unroll
        for (int it = 0; it < 20; ++it) { const int i = tid + 512 * it, b = i >> 10, k = i & 1023; const float c = b < 2 ? p.c_prompt[b * 1024 + k] : p.c_sample[(b - 2) * 1024 + k]; sc[i] = silu_f(c); }
        __syncthreads();
        float acc[10];
#pragma unroll
        for (int b = 0; b < 10; ++b) acc[b] = 0.f;
#pragma unroll
        for (int i = 0; i < 32; ++i) { const int k = wave * 128 + i * 4 + ks; const float w = wv[i];
#pragma unroll
            for (int b = 0; b < 10; ++b) acc[b] += sc[b * 1024 + k] * w; }
#pragma unroll
        for (int b = 0; b < 10; ++b) { acc[b] += __shfl_xor(acc[b], 16); acc[b] += __shfl_xor(acc[b], 32); }
        if (lane < 16) {
#pragma unroll
            for (int b = 0; b < 10; ++b) red[(wave * 10 + b) * 16 + j] = acc[b]; }
        __syncthreads();
        if (tid < 160) { const int b = tid >> 4, jj = tid & 15; float s = p.b_ada[j0 + jj];
#pragma unroll
            for (int w = 0; w < 8; ++w) s += red[(w * 10 + b) * 16 + jj];
            p.MOD[b * 3072 + j0 + jj] = s; }
        __syncthreads();
    }
}

__device__ __forceinline__ void phase0b(const P& p, LAS unsigned char* lds, int tid, int wave, int lane) {
    if (blockIdx.x == 0 && tid < 8) p.QCTR[64 * tid] = 0u;
    if (blockIdx.x == 1 && tid < 128) p.PCNT[64 * tid] = 0u;
    LAS float* scr = (LAS float*)(lds + wave * 16384);
    const int gw = blockIdx.x * 8 + wave, NGW = gridDim.x * 8;
    constexpr int I_IN = (DM / 64) * (DIN / 32), I_OUT = (DM / 64) * (DM / 32);
    for (int it = gw; it < I_IN + I_OUT; it += NGW) {
        if (it < I_IN) {
            const int n0 = 32 * (it % (DIN / 32)); int np = n0;
            if (n0 < 512) np = 256 * (n0 >> 7) + (n0 & 127); else if (n0 < 1024) np = n0 + 512; else if (n0 < 1536) np = 256 * ((n0 - 1024) >> 7) + 128 + ((n0 - 1024) & 127);
            p0_transpose_item(p.w_in, DM, DIN, p.WIN, np - n0, scr, it, lane); }
        else p0_transpose_item(p.w_out, DM, DM, p.WOUT, 0, scr, it - I_IN, lane);
    }
    for (int i = blockIdx.x * 512 + tid; i < 8 * 128 * 128; i += gridDim.x * 512) { const int t = (i >> 7) & 127, s = i & 127; p.WST[i] = (bf16_t)f2bf(s <= t ? p.w_s[i] : 0.f); }
}

__device__ __forceinline__ const float* p1_row(const P& p, int m) { return m < MP ? p.x_prompt + (size_t)m * DM : p.x_sample + (size_t)(m - MP) * DM; }
__device__ __forceinline__ void phase1(const P& p, int wave, int lane) {
    const int gw = blockIdx.x * 8 + wave, NGW = gridDim.x * 8, NR = MP + MS, RPW = (NR + NGW - 1) / NGW;
    const int m0 = gw * RPW, m1 = (m0 + RPW < NR) ? m0 + RPW : NR;
    constexpr int PD = 4;
    f32x4 v[4], nx[PD][4];
#pragma unroll
    for (int d = 0; d < PD; ++d) if (m0 + d < m1) { const f32x4* xr = (const f32x4*)p1_row(p, m0 + d) + lane;
#pragma unroll
        for (int j = 0; j < 4; ++j) nx[d][j] = xr[64 * j]; }
    f32x4 ga[4], sh[4]; int bcur = -1;
    for (int m = m0; m < m1; ++m) {
#pragma unroll
        for (int j = 0; j < 4; ++j) { v[j] = nx[0][j];
#pragma unroll
            for (int d = 0; d + 1 < PD; ++d) nx[d][j] = nx[d + 1][j]; }
        if (m + PD < m1) { const f32x4* xr = (const f32x4*)p1_row(p, m + PD) + lane;
#pragma unroll
            for (int j = 0; j < 4; ++j) nx[PD - 1][j] = xr[64 * j]; }
        const int b = m < MP ? (m >> 14) : 2 + ((m - MP) >> 4);
        if (b != bcur) { bcur = b; const float* mod = p.MOD + b * 3072;
#pragma unroll
            for (int j = 0; j < 4; ++j) { const int c = 4 * lane + 256 * j; ga[j] = *(const f32x4*)(p.g_pre + c) * (*(const f32x4*)(mod + 1024 + c) + 1.f); sh[j] = *(const f32x4*)(mod + c); } }
        float s = 0.f;
#pragma unroll
        for (int j = 0; j < 4; ++j) s += (v[j].x * v[j].x + v[j].y * v[j].y) + (v[j].z * v[j].z + v[j].w * v[j].w);
        const float rstd = rsqrtf(wave_sum(s) * (1.f / DM) + EPS);
        u32x2* o8 = (u32x2*)(p.XN + (size_t)m * DM) + lane;
#pragma unroll
        for (int j = 0; j < 4; ++j) { const f32x4 hh = v[j] * rstd * ga[j] + sh[j];
            u32x2 w; w.x = pkbf(hh.x, hh.y); w.y = pkbf(hh.z, hh.w); o8[64 * j] = w; }
    }
}

struct EpiIn {
    static constexpr bool PERM = true, AFTER_DRAIN = false;
    bf16_t* ZB; bf16_t* GVT; bf16_t* VT; float* STATS; float* outK; float* outV;
    __device__ __forceinline__ void operator()(const f32x4 (&acc)[2][2][4][2], const pg8::Unit& u, int wr, int wc, int fr, int fq) const {
        const int seg = u.pn < 4 ? 7 : (u.pn < 6 ? 1 : u.pn >> 1), cs0 = (u.pn & 1) * 256 + wc * 32 + 8 * fq, row0 = u.pm * 256 + wr * 64 + fr;
        if (seg == 7) {
            const int ch = u.pn * 128 + wc * 32 + 8 * fq;
#pragma unroll
            for (int ai = 0; ai < 2; ++ai)
#pragma unroll
                for (int m = 0; m < 4; ++m) { const int row = row0 + ai * 128 + m * 16, b = row >> 14, t = row & (T - 1); float v[8];
#pragma unroll
                    for (int i = 0; i < 4; ++i) { v[i] = gelu_t(acc[ai][0][m][0][i]) * silu_f(acc[ai][1][m][0][i]); v[4 + i] = gelu_t(acc[ai][0][m][1][i]) * silu_f(acc[ai][1][m][1][i]); }
                    u32x4 w; w.x = pkbf(v[0], v[1]); w.y = pkbf(v[2], v[3]); w.z = pkbf(v[4], v[5]); w.w = pkbf(v[6], v[7]);
                    *(u32x4*)(ZB + zb_off(0, b, ch >> 6, t) + (ch & 63)) = w; }
        } else if (seg == 1 || seg == 5) {
#pragma unroll
            for (int ai = 0; ai < 2; ++ai)
#pragma unroll
                for (int m = 0; m < 4; ++m) { const int row = row0 + ai * 128 + m * 16, b = row >> 14, t = row & (T - 1);
                    float s1 = 0.f, s2 = 0.f;
#pragma unroll
                    for (int bj = 0; bj < 2; ++bj) { const int cs = cs0 + bj * 128; float v[8];
#pragma unroll
                        for (int i = 0; i < 4; ++i) { v[i] = acc[ai][bj][m][0][i]; v[4 + i] = acc[ai][bj][m][1][i]; }
                        if (seg == 1) {
#pragma unroll
                            for (int i = 0; i < 8; ++i) { v[i] = gelu_t(v[i]); s1 += v[i]; s2 += v[i] * v[i]; } }
                        else if (t >= T - 512) { float* o = outV + ((size_t)(b * 512 + t - (T - 512))) * 512 + cs;
                            *(f32x4*)o = (f32x4){v[0], v[1], v[2], v[3]}; *(f32x4*)(o + 4) = (f32x4){v[4], v[5], v[6], v[7]}; }
                        bf16_t* d = (seg == 1) ? GVT + (((size_t)(b * 128 + (t >> 7))) * 512 + cs) * 128 + (t & 127) : VT + ((((size_t)(b * 8 + (cs >> 6))) * 256 + (t >> 6)) * 64 + (cs & 63)) * 64 + (t & 63);
                        const int ds = (seg == 1) ? 128 : 64;
#pragma unroll
                        for (int i = 0; i < 4; ++i) { const unsigned w = pkbf(v[2 * i], v[2 * i + 1]); d[(2 * i) * ds] = (bf16_t)(w & 0xffffu); d[(2 * i + 1) * ds] = (bf16_t)(w >> 16); }
                    }
                    if (seg == 1) { s1 += __shfl_xor(s1, 16); s1 += __shfl_xor(s1, 32); s2 += __shfl_xor(s2, 16); s2 += __shfl_xor(s2, 32);
                        if (fq == 0) { f32x2_t sv = {s1, s2}; *(f32x2_t*)(STATS + (size_t)row * 16 + ((u.pn & 1) * 4 + wc) * 2) = sv; } }
                }
        } else {
#pragma unroll
            for (int ai = 0; ai < 2; ++ai)
#pragma unroll
                for (int m = 0; m < 4; ++m) { const int row = row0 + ai * 128 + m * 16, b = row >> 14, t = row & (T - 1);
#pragma unroll
                    for (int bj = 0; bj < 2; ++bj) { const int cs = cs0 + bj * 128; float v[8];
#pragma unroll
                        for (int i = 0; i < 4; ++i) { v[i] = acc[ai][bj][m][0][i]; v[4 + i] = acc[ai][bj][m][1][i]; }
                        if (seg == 0) {
#pragma unroll
                            for (int i = 0; i < 8; ++i) v[i] = gelu_t(v[i]); }
                        else if (seg == 2 || seg == 6) {
#pragma unroll
                            for (int i = 0; i < 8; ++i) v[i] = silu_f(v[i]); }
                        else if (seg == 3) {
#pragma unroll
                            for (int i = 0; i < 8; ++i) v[i] *= 0.125f; }
                        else if (t >= T - 512) { float* o = outK + ((size_t)(b * 512 + t - (T - 512))) * 512 + cs;
                            *(f32x4*)o = (f32x4){v[0], v[1], v[2], v[3]}; *(f32x4*)(o + 4) = (f32x4){v[4], v[5], v[6], v[7]}; }
                        u32x4 w; w.x = pkbf(v[0], v[1]); w.y = pkbf(v[2], v[3]); w.z = pkbf(v[4], v[5]); w.w = pkbf(v[6], v[7]);
                        *(u32x4*)(ZB + zb_off(seg, b, cs >> 6, t) + (cs & 63)) = w; }
                }
        }
    }
};
struct EpiOut {
    static constexpr bool PERM = true, AFTER_DRAIN = false;
    const float* x; float* y; const float* MOD; const float* g_post; float* slot; unsigned* cnt;
    __device__ __forceinline__ void operator()(const f32x4 (&acc)[2][2][4][2], const pg8::Unit& u, int wr, int wc, int fr, int fq) const {
        const int c0 = u.pn * 256 + wc * 32 + 8 * fq, row0 = u.pm * 256 + wr * 64 + fr;
        float ssq[2][4];
#pragma unroll
        for (int ai = 0; ai < 2; ++ai)
#pragma unroll
            for (int m = 0; m < 4; ++m) { float s = 0.f;
#pragma unroll
                for (int bj = 0; bj < 2; ++bj)
#pragma unroll
                    for (int n = 0; n < 2; ++n) { const f32x4 v = acc[ai][bj][m][n]; s += (v[0] * v[0] + v[1] * v[1]) + (v[2] * v[2] + v[3] * v[3]); }
                s += __shfl_xor(s, 16); s += __shfl_xor(s, 32); ssq[ai][m] = s; }
        if (fq == 0) {
#pragma unroll
            for (int ai = 0; ai < 2; ++ai)
#pragma unroll
                for (int m = 0; m < 4; ++m) __hip_atomic_store(slot + (size_t)(row0 + ai * 128 + m * 16) * 16 + u.pn * 4 + wc, ssq[ai][m], __ATOMIC_RELAXED, __HIP_MEMORY_SCOPE_AGENT); }
        asm volatile("s_waitcnt vmcnt(0)" ::: "memory");
        unsigned* pc = cnt + 64 * u.pm;
        if (fq == 0 && fr == 0) __hip_atomic_fetch_add(pc, 1u, __ATOMIC_RELAXED, __HIP_MEMORY_SCOPE_AGENT);
        const float* gate = MOD + (u.pm >> 6) * 3072 + 2048;
        f32x4 gg[2][2];
#pragma unroll
        for (int bj = 0; bj < 2; ++bj)
#pragma unroll
            for (int n = 0; n < 2; ++n) gg[bj][n] = *(const f32x4*)(gate + c0 + bj * 128 + 4 * n) * *(const f32x4*)(g_post + c0 + bj * 128 + 4 * n);
        const unsigned voff = (unsigned)((wr * 64 + fr) * DM + c0) * 4u;
        const char* xb = (const char*)(x + (size_t)(u.pm * 256) * DM); char* yb = (char*)(y + (size_t)(u.pm * 256) * DM);
        f32x4 xa[3][2][2];
#pragma unroll
        for (int k = 0; k < 3; ++k)
#pragma unroll
            for (int bj = 0; bj < 2; ++bj)
#pragma unroll
                for (int n = 0; n < 2; ++n) xa[k][bj][n] = *(const f32x4*)(xb + (size_t)(k * 16) * DM * 4 + voff + (bj * 128 + 4 * n) * 4);
        { unsigned spins = 0;
          while ((unsigned)__builtin_amdgcn_readfirstlane((int)__hip_atomic_load(pc, __ATOMIC_RELAXED, __HIP_MEMORY_SCOPE_AGENT)) < 32u) { __builtin_amdgcn_s_sleep(2); if (++spins > (1u << 24)) break; } }
        asm volatile("" ::: "memory");
        float rstd[2][4];
#pragma unroll
        for (int ai = 0; ai < 2; ++ai)
#pragma unroll
            for (int m = 0; m < 4; ++m) { const unsigned long long* sp = (const unsigned long long*)((const char*)(slot + (size_t)(u.pm * 256 + ai * 128 + m * 16) * 16) + (unsigned)((wr * 64 + fr) * 16 + 4 * fq) * 4u);
                const unsigned long long w0 = __hip_atomic_load(sp, __ATOMIC_RELAXED, __HIP_MEMORY_SCOPE_AGENT), w1 = __hip_atomic_load(sp + 1, __ATOMIC_RELAXED, __HIP_MEMORY_SCOPE_AGENT);
                float t = (__uint_as_float((unsigned)w0) + __uint_as_float((unsigned)(w0 >> 32))) + (__uint_as_float((unsigned)w1) + __uint_as_float((unsigned)(w1 >> 32)));
                rstd[ai][m] = t; }
#pragma unroll
        for (int ai = 0; ai < 2; ++ai)
#pragma unroll
            for (int m = 0; m < 4; ++m) { float t = rstd[ai][m]; t += __shfl_xor(t, 16); t += __shfl_xor(t, 32); rstd[ai][m] = rsqrtf(t * (1.f / DM) + EPS); }
#pragma unroll
        for (int k = 0; k < 8; ++k) { const int ai = k >> 2, m = k & 3;
#pragma unroll
            for (int bj = 0; bj < 2; ++bj)
#pragma unroll
                for (int n = 0; n < 2; ++n) *(f32x4*)(yb + (size_t)(ai * 128 + m * 16) * DM * 4 + voff + (bj * 128 + 4 * n) * 4) = xa[k % 3][bj][n] + gg[bj][n] * (acc[ai][bj][m][n] * rstd[ai][m]);
            if (k + 3 < 8) { const int k2 = k + 3, ai2 = k2 >> 2, m2 = k2 & 3;
#pragma unroll
                for (int bj = 0; bj < 2; ++bj)
#pragma unroll
                    for (int n = 0; n < 2; ++n) xa[k % 3][bj][n] = *(const f32x4*)(xb + (size_t)(ai2 * 128 + m2 * 16) * DM * 4 + voff + (bj * 128 + 4 * n) * 4); }
        }
    }
};

__device__ __forceinline__ f32x4 small_gemm(const bf16_t* A, const bf16_t* Bt, int n0, int wave, int lane) {
    const int fr = lane & 15, fq = lane >> 4;
    const bf16x8* ap = (const bf16x8*)(A + (size_t)(wave * 16 + fr) * DM + 8 * fq);
    const bf16x8* bp = (const bf16x8*)(Bt + (size_t)(n0 + fr) * DM + 8 * fq);
    f32x4 acc = {0.f, 0.f, 0.f, 0.f};
#pragma unroll 16
    for (int ks = 0; ks < 32; ++ks) acc = __builtin_amdgcn_mfma_f32_16x16x32_bf16(bp[ks * 4], ap[ks * 4], acc, 0, 0, 0);
    return acc;
}
#ifdef TPROBE
__device__ unsigned long long tp_last, tp_acc;
#define TP_T0() do { asm volatile("s_waitcnt lgkmcnt(0)" ::: "memory"); tp_t = wall_clock64(); } while (0)
#define TP_MARK(k) do { asm volatile("s_waitcnt lgkmcnt(0)" ::: "memory"); __builtin_amdgcn_sched_barrier(0); const unsigned long long n_ = wall_clock64(); if (TPROBE == (k)) tp_sum += n_ - tp_t; tp_t = n_; } while (0)
#else
#define TP_T0() do {} while (0)
#define TP_MARK(k) do {} while (0)
#endif
#define MFMA32(a, b, c) __builtin_amdgcn_mfma_f32_32x32x16_bf16((a), (b), (c), 0, 0, 0)
__device__ __forceinline__ void attn_unit(const P& p, int b, int h, int ci, const LAS float* biasL, LAS unsigned char* wl, int lane, unsigned long long& tp_sum) {
    unsigned long long tp_t = 0; (void)tp_t;
    constexpr float LOG2E = 1.4426950408889634f;
    const int r = lane & 31, h2 = lane >> 5;
    const size_t rowbase = (size_t)b * T;
    bf16x8 qf[2][4];
#pragma unroll
    for (int qt = 0; qt < 2; ++qt)
#pragma unroll
        for (int ks = 0; ks < 4; ++ks) qf[qt][ks] = *(const bf16x8*)(p.ZB + zb_off(3, b, h, ci * 64 + qt * 32 + r) + 16 * ks + 8 * h2);
    f32x16 o[2][2];
#pragma unroll
    for (int dt = 0; dt < 2; ++dt)
#pragma unroll
        for (int qt = 0; qt < 2; ++qt)
#pragma unroll
            for (int i = 0; i < 16; ++i) o[dt][qt][i] = 0.f;
    float m_used[2] = {-1e30f, -1e30f}, lsum[2] = {0.f, 0.f};
    const int cj0 = ci > 8 ? ci - 8 : 0, nblk = (ci - cj0 + 1) * 2, key_start = cj0 * 64;
    const int krow = lane >> 3, kch = lane & 7, vrow = lane >> 2, vch = lane & 3;
    const char* kg = (const char*)(p.ZB + zb_off(4, b, h, key_start));
    const char* vg = (const char*)(p.VT + (((size_t)(b * 8 + h)) * 256 + cj0) * 4096);
    const unsigned koff = (unsigned)(krow * 64 + 8 * kch) * 2u, voff = (unsigned)(vrow * 64 + 8 * vch) * 2u;
    LAS unsigned char* Ks = wl; LAS unsigned char* Vs = wl + 4608;
    LAS unsigned char* kw = Ks + krow * 144 + kch * 16; LAS unsigned char* vw = Vs + vrow * 72 + vch * 16;
    const LAS unsigned char* kr = Ks + r * 144 + h2 * 16; const LAS unsigned char* vr = Vs + r * 72 + h2 * 8;
    u32x4 sk[4], sv[4];
#pragma unroll
    for (int i = 0; i < 4; ++i) { sk[i] = *(const u32x4*)(kg + i * 1024 + koff); sv[i] = *(const u32x4*)(vg + i * 2048 + voff); }
    for (int blk = 0; blk < nblk; ++blk) {
        TP_T0();
        const int key0 = key_start + blk * 32;
#pragma unroll
        for (int i = 0; i < 4; ++i) { *(LAS u32x4*)(kw + i * 8 * 144) = sk[i];
            u32x2 lo = {sv[i].x, sv[i].y}, hi = {sv[i].z, sv[i].w}; *(LAS u32x2*)(vw + i * 16 * 72) = lo; *(LAS u32x2*)(vw + i * 16 * 72 + 8) = hi; }
        { const int nb = blk + 1 < nblk ? blk + 1 : blk;
#pragma unroll
          for (int i = 0; i < 4; ++i) { sk[i] = *(const u32x4*)(kg + (size_t)nb * 4096 + i * 1024 + koff); sv[i] = *(const u32x4*)(vg + (size_t)(nb >> 1) * 8192 + (nb & 1) * 64 + i * 2048 + voff); } }
        bf16x8 kf[4];
#pragma unroll
        for (int ks = 0; ks < 4; ++ks) kf[ks] = *(const LAS bf16x8*)(kr + ks * 32);
        TP_MARK(1);
        const bool far = key0 + 31 + 128 <= ci * 64;
        const float bcst = far ? biasL[256] : 0.f;
#pragma unroll
        for (int qt = 0; qt < 2; ++qt) {
            bf16x8 pf[2];
            f32x16 s;
#pragma unroll
            for (int i = 0; i < 16; ++i) s[i] = 0.f;
#pragma unroll
            for (int ks = 0; ks < 4; ++ks) s = MFMA32(kf[ks], qf[qt][ks], s);
            if (!far) {
#pragma unroll
                for (int i = 0; i < 16; ++i) { const int key = key0 + (i & 3) + 8 * (i >> 2) + 4 * h2; int dist = ci * 64 + qt * 32 + r - key; dist = dist < -128 ? -128 : (dist > 128 ? 128 : dist); s[i] += biasL[dist + 128]; }
            }
            float a = fmaxf(s[0], s[1]);
#pragma unroll
            for (int i = 2; i < 16; i += 2) a = fmaxf(a, fmaxf(s[i], s[i + 1]));
            const float mx = fmaxf(a, __shfl_xor(a, 32)) + bcst;
            if (__builtin_amdgcn_ballot_w64(mx > m_used[qt] + 8.f) != 0ull) {
                const float mnew = fmaxf(m_used[qt], mx), alpha = __builtin_amdgcn_exp2f((m_used[qt] - mnew) * LOG2E); lsum[qt] *= alpha; m_used[qt] = mnew;
#pragma unroll
                for (int dt = 0; dt < 2; ++dt)
#pragma unroll
                    for (int i = 0; i < 16; ++i) o[dt][qt][i] *= alpha;
            }
            const float cb = (bcst - m_used[qt]) * LOG2E;
#pragma unroll
            for (int i = 0; i < 16; ++i) { const float e = __builtin_amdgcn_exp2f(s[i] * LOG2E + cb); s[i] = e; lsum[qt] += e; }
#pragma unroll
            for (int sp = 0; sp < 2; ++sp) { u32x4 w; w.x = pkbf(s[8 * sp], s[8 * sp + 1]); w.y = pkbf(s[8 * sp + 2], s[8 * sp + 3]); w.z = pkbf(s[8 * sp + 4], s[8 * sp + 5]); w.w = pkbf(s[8 * sp + 6], s[8 * sp + 7]);
                pf[sp] = __builtin_bit_cast(bf16x8, w); }
            if (qt == 0) TP_MARK(2);
#pragma unroll
            for (int dt = 0; dt < 2; ++dt)
#pragma unroll
                for (int sp = 0; sp < 2; ++sp) { const u32x2 v0 = *(const LAS u32x2*)(vr + dt * 32 * 72 + sp * 32), v1 = *(const LAS u32x2*)(vr + dt * 32 * 72 + sp * 32 + 16);
                    u32x4 w; w.x = v0.x; w.y = v0.y; w.z = v1.x; w.w = v1.y; const bf16x8 vf = __builtin_bit_cast(bf16x8, w);
                    o[dt][qt] = MFMA32(vf, pf[sp], o[dt][qt]); }
        }
        TP_MARK(3);
    }
#pragma unroll
    for (int qt = 0; qt < 2; ++qt) { const float l = lsum[qt] + __shfl_xor(lsum[qt], 32), inv = 1.f / l;
#pragma unroll
        for (int dt = 0; dt < 2; ++dt)
#pragma unroll
            for (int g4 = 0; g4 < 4; ++g4) { const f32x4 v = {o[dt][qt][4 * g4] * inv, o[dt][qt][4 * g4 + 1] * inv, o[dt][qt][4 * g4 + 2] * inv, o[dt][qt][4 * g4 + 3] * inv};
                *(LAS f32x4*)(wl + r * 272 + (32 * dt + 8 * g4 + 4 * h2) * 4) = v; }
        const int er = lane >> 4, ec = (lane & 15) * 4;
#pragma unroll
        for (int i = 0; i < 8; ++i) { const int q = er + 4 * i; const f32x4 v = *(const LAS f32x4*)(wl + q * 272 + ec * 4); const size_t row = rowbase + ci * 64 + qt * 32 + q;
            const u32x2 gb = *(const u32x2*)(p.ZB + zb_off(6, b, h, ci * 64 + qt * 32 + q) + ec);
            u32x2 w; w.x = pkbf(v.x * bflo(gb.x), v.y * bfhi(gb.x)); w.y = pkbf(v.z * bflo(gb.y), v.w * bfhi(gb.y));
            *(u32x2*)(p.XN + row * DM + 512 + h * 64 + ec) = w; }
    }
}

__device__ __forceinline__ void gmlp_unit(const P& p, int b, int n, int g, LAS float* scr, int lane) {
    const int r = lane & 31, h2 = lane >> 5;
    const size_t rowbase = (size_t)b * T + n * 128;
    const bf16_t* abase = p.GVT + (((size_t)(b * 128 + n)) * 512 + g * 64 + r) * 128 + 8 * h2;
    const bf16_t* wbase = p.WST + ((size_t)(g * 128 + r)) * 128 + 8 * h2;
    f32x4 sa[2][4]; u32x4 raw[2][8]; bf16x8 wf[8];
#pragma unroll
    for (int e = 0; e < 2; ++e) { const f32x4* sp = (const f32x4*)(p.STATS + (rowbase + lane + 64 * e) * 16);
#pragma unroll
        for (int i = 0; i < 4; ++i) sa[e][i] = sp[i]; }
#pragma unroll
    for (int dt = 0; dt < 2; ++dt)
#pragma unroll
        for (int ks = 0; ks < 8; ++ks) raw[dt][ks] = *(const u32x4*)(abase + dt * 32 * 128 + 16 * ks);
#pragma unroll
    for (int ks = 0; ks < 2; ++ks) wf[ks] = *(const bf16x8*)(wbase + 16 * ks);
    float lg[2], lb[2];
#pragma unroll
    for (int dt = 0; dt < 2; ++dt) { lg[dt] = p.ln_g[g * 64 + 32 * dt + r]; lb[dt] = p.ln_b[g * 64 + 32 * dt + r]; }
#pragma unroll
    for (int e = 0; e < 2; ++e) { const int tl = lane + 64 * e; const f32x4 a0 = sa[e][0], a1 = sa[e][1], a2 = sa[e][2], a3 = sa[e][3];
        const float s1 = ((a0.x + a0.z) + (a1.x + a1.z)) + ((a2.x + a2.z) + (a3.x + a3.z)), s2 = ((a0.y + a0.w) + (a1.y + a1.w)) + ((a2.y + a2.w) + (a3.y + a3.w));
        const float mean = s1 * (1.f / 512.f), var = fmaxf(s2 * (1.f / 512.f) - mean * mean, 0.f), rstd = rsqrtf(var + EPS);
        f32x2_t sv = {rstd, -mean * rstd}; *(LAS f32x2_t*)(scr + tl * 2) = sv; }
    bf16x8 af[2][8];
#pragma unroll
    for (int ks = 0; ks < 8; ++ks) {
        f32x4 st[4];
#pragma unroll
        for (int i = 0; i < 4; ++i) st[i] = *(const LAS f32x4*)(scr + (16 * ks + 8 * h2) * 2 + 4 * i);
#pragma unroll
        for (int dt = 0; dt < 2; ++dt) { u32x4 w;
#pragma unroll
            for (int i = 0; i < 4; ++i) { const float x0 = bflo(raw[dt][ks][i]), x1 = bfhi(raw[dt][ks][i]);
                const float y0 = x0 * (st[i].x * lg[dt]) + (st[i].y * lg[dt] + lb[dt]), y1 = x1 * (st[i].z * lg[dt]) + (st[i].w * lg[dt] + lb[dt]); w[i] = pkbf(y0, y1); }
            af[dt][ks] = __builtin_bit_cast(bf16x8, w); }
    }
    LAS unsigned char* wl = (LAS unsigned char*)scr;
    const int er = lane >> 4, ec = (lane & 15) * 4;
#pragma unroll
    for (int tt = 0; tt < 4; ++tt) {
        bf16x8 wn[8];
        if (tt < 3) {
#pragma unroll
            for (int ks = 0; ks < 2 * tt + 4; ++ks) wn[ks] = *(const bf16x8*)(wbase + (size_t)((tt + 1) * 32) * 128 + 16 * ks); }
        u32x2 uu[8];
#pragma unroll
        for (int i = 0; i < 8; ++i) { const int t = n * 128 + 32 * tt + er + 4 * i; uu[i] = *(const u32x2*)(p.ZB + zb_off(0, b, g, t) + ec); }
        const float bs = p.b_s[g * 128 + 32 * tt + r];
        f32x16 acc[2];
#pragma unroll
        for (int dt = 0; dt < 2; ++dt)
#pragma unroll
            for (int i = 0; i < 16; ++i) acc[dt][i] = 0.f;
#pragma unroll
        for (int ks = 0; ks < 2 * tt + 2; ++ks)
#pragma unroll
            for (int dt = 0; dt < 2; ++dt) acc[dt] = MFMA32(af[dt][ks], wf[ks], acc[dt]);
#pragma unroll
        for (int dt = 0; dt < 2; ++dt)
#pragma unroll
            for (int g4 = 0; g4 < 4; ++g4) { const f32x4 v = {acc[dt][4 * g4] + bs, acc[dt][4 * g4 + 1] + bs, acc[dt][4 * g4 + 2] + bs, acc[dt][4 * g4 + 3] + bs};
                *(LAS f32x4*)(wl + r * 272 + (32 * dt + 8 * g4 + 4 * h2) * 4) = v; }
#pragma unroll
        for (int i = 0; i < 8; ++i) { const int tl = er + 4 * i; const f32x4 v = *(const LAS f32x4*)(wl + tl * 272 + ec * 4); const size_t row = rowbase + 32 * tt + tl;
            u32x2 w; w.x = pkbf(bflo(uu[i].x) * v.x, bfhi(uu[i].x) * v.y); w.y = pkbf(bflo(uu[i].y) * v.z, bfhi(uu[i].y) * v.w);
            *(u32x2*)(p.XN + row * DM + g * 64 + ec) = w; }
        if (tt < 3) {
#pragma unroll
            for (int ks = 0; ks < 2 * tt + 4; ++ks) wf[ks] = wn[ks]; }
    }
}

__device__ __forceinline__ void sgmlp_unit(const P& p, int b, int g, int lane) {
    const int c = g * 64 + lane; const float lgc = p.ln_g[c], lbc = p.ln_b[c];
    float vn[16];
#pragma unroll
    for (int s = 0; s < 16; ++s) { const int row = b * 16 + s; const float* zr = p.ZS + (size_t)row * DIN + SEG_V;
        const f32x4 a = *(const f32x4*)(zr + 4 * lane), bq = *(const f32x4*)(zr + 256 + 4 * lane);
        const float mean = wave_sum((a.x + a.y) + (a.z + a.w) + (bq.x + bq.y) + (bq.z + bq.w)) * (1.f / 512.f);
        const f32x4 da = a - mean, db = bq - mean;
        const float var = wave_sum((da.x * da.x + da.y * da.y) + (da.z * da.z + da.w * da.w) + (db.x * db.x + db.y * db.y) + (db.z * db.z + db.w * db.w)) * (1.f / 512.f);
        vn[s] = (zr[c] - mean) * rsqrtf(var + EPS) * lgc + lbc;
        p.out[OUT_GV + (size_t)row * 512 + c] = vn[s]; }
#pragma unroll
    for (int t = 0; t < 16; ++t) { float acc = 0.f;
#pragma unroll
        for (int s = 0; s <= t; ++s) acc += p.w_s[(size_t)g * 16384 + t * 128 + s] * vn[s];
        const int row = b * 16 + t; const float* zr = p.ZS + (size_t)row * DIN;
        const float y = zr[SEG_U + c] * (acc + p.b_s[g * 128 + t]) * zr[SEG_G + c];
        p.XN[(size_t)(MP + row) * DM + c] = (bf16_t)f2bf(y); }
}
__device__ __forceinline__ void sattn_block(const P& p, int b, int t, LAS float* part, const LAS float* biasL, int wave, int lane) {
    const int head = lane >> 3, sub = lane & 7, row = b * 16 + t, hoff = head * 64 + 8 * sub;
    const float* zq = p.ZS + (size_t)row * DIN + SEG_Q + hoff;
    const f32x4 q0 = *(const f32x4*)zq, q1 = *(const f32x4*)(zq + 4);
    float m = -1e30f, l = 0.f; f32x4 a0 = {0.f, 0.f, 0.f, 0.f}, a1 = {0.f, 0.f, 0.f, 0.f};
    const LAS float* bh = biasL + head * 257;
    const float* kc = p.cache_k + ((size_t)(b * 512 + wave * 64)) * 512 + hoff; const float* vc = p.cache_v + ((size_t)(b * 512 + wave * 64)) * 512 + hoff;
    asm volatile("; SATTN_LOOP_BEGIN");
#pragma unroll 1
    for (int bt = 0; bt < 8; ++bt) {
        f32x4 k0[8], k1[8], v0[8], v1[8]; float s[8];
#pragma unroll
        for (int j = 0; j < 8; ++j) { const size_t o = (size_t)(bt * 8 + j) * 512; k0[j] = *(const f32x4*)(kc + o); k1[j] = *(const f32x4*)(kc + o + 4); v0[j] = *(const f32x4*)(vc + o); v1[j] = *(const f32x4*)(vc + o + 4); }
        float mx = -1e30f;
#pragma unroll
        for (int j = 0; j < 8; ++j) { const int kk = wave * 64 + bt * 8 + j;
            float a = ((q0.x * k0[j].x + q0.y * k0[j].y) + (q0.z * k0[j].z + q0.w * k0[j].w)) + ((q1.x * k1[j].x + q1.y * k1[j].y) + (q1.z * k1[j].z + q1.w * k1[j].w));
            a += __shfl_xor(a, 1); a += __shfl_xor(a, 2); a += __shfl_xor(a, 4);
            int dist = 512 + t - kk; dist = dist > 128 ? 128 : dist;
            s[j] = a + bh[dist + 128]; mx = fmaxf(mx, s[j]); }
        const float mnew = fmaxf(m, mx), alpha = __expf(m - mnew);
        l *= alpha; a0 = a0 * alpha; a1 = a1 * alpha; m = mnew;
#pragma unroll
        for (int j = 0; j < 8; ++j) { const float e = __expf(s[j] - m); l += e; a0 += v0[j] * e; a1 += v1[j] * e; }
    }
    asm volatile("; SATTN_LOOP_END");
    { f32x4 k0[2], k1[2], v0[2], v1[2]; float s[2];
#pragma unroll
        for (int j = 0; j < 2; ++j) { const float* zr = p.ZS + (size_t)(b * 16 + 2 * wave + j) * DIN + hoff; k0[j] = *(const f32x4*)(zr + SEG_K); k1[j] = *(const f32x4*)(zr + SEG_K + 4); v0[j] = *(const f32x4*)(zr + SEG_VV); v1[j] = *(const f32x4*)(zr + SEG_VV + 4); }
#pragma unroll
        for (int j = 0; j < 2; ++j) {
            float a = ((q0.x * k0[j].x + q0.y * k0[j].y) + (q0.z * k0[j].z + q0.w * k0[j].w)) + ((q1.x * k1[j].x + q1.y * k1[j].y) + (q1.z * k1[j].z + q1.w * k1[j].w));
            a += __shfl_xor(a, 1); a += __shfl_xor(a, 2); a += __shfl_xor(a, 4);
            s[j] = a + bh[t - (2 * wave + j) + 128]; }
        const float mnew = fmaxf(m, fmaxf(s[0], s[1])), alpha = __expf(m - mnew);
        l *= alpha; a0 = a0 * alpha; a1 = a1 * alpha; m = mnew;
#pragma unroll
        for (int j = 0; j < 2; ++j) { const float e = __expf(s[j] - m); l += e; a0 += v0[j] * e; a1 += v1[j] * e; }
    }
    LAS float* pp = part + (wave * 64 + lane) * 12;
    pp[0] = m; pp[1] = l; *(LAS f32x4*)(pp + 4) = a0; *(LAS f32x4*)(pp + 8) = a1;
    __syncthreads();
    if (wave == 0) { float M = -1e30f;
#pragma unroll
        for (int w = 0; w < 8; ++w) M = fmaxf(M, part[(w * 64 + lane) * 12]);
        float L = 0.f; f32x4 o0 = {0.f, 0.f, 0.f, 0.f}, o1 = {0.f, 0.f, 0.f, 0.f};
#pragma unroll
        for (int w = 0; w < 8; ++w) { const LAS float* q = part + (w * 64 + lane) * 12; const float f = __expf(q[0] - M); L += q[1] * f; o0 += *(const LAS f32x4*)(q + 4) * f; o1 += *(const LAS f32x4*)(q + 8) * f; }
        const float inv = 1.f / L; const float* gp = p.ZS + (size_t)row * DIN + SEG_GB + hoff; const f32x4 g0 = *(const f32x4*)gp, g1 = *(const f32x4*)(gp + 4);
        u32x4 w; w.x = pkbf(o0.x * inv * g0.x, o0.y * inv * g0.y); w.y = pkbf(o0.z * inv * g0.z, o0.w * inv * g0.w); w.z = pkbf(o1.x * inv * g1.x, o1.y * inv * g1.y); w.w = pkbf(o1.z * inv * g1.z, o1.w * inv * g1.w);
        *(u32x4*)(p.XN + (size_t)(MP + row) * DM + 512 + hoff) = w; }
    __syncthreads();
}

__device__ __forceinline__ void phase5(const P& p, int wave, int lane) {
    const int gw = blockIdx.x * 8 + wave, NGW = gridDim.x * 8;
    for (int ms = gw; ms < MS; ms += NGW) {
        const int b = 2 + (ms >> 4); const float* xrow = p.x_sample + (size_t)ms * DM; float* yrow = p.out + OUT_YS + (size_t)ms * DM;
        f32x4 ov[4]; float ss = 0.f;
#pragma unroll
        for (int j = 0; j < 2; ++j)
#pragma unroll
            for (int i = 0; i < 2; ++i) { ov[2 * j + i] = *(const f32x4*)(p.OS + (size_t)ms * DM + 8 * lane + 512 * j + 4 * i); const f32x4 w = ov[2 * j + i]; ss += (w.x * w.x + w.y * w.y) + (w.z * w.z + w.w * w.w); }
        const float rstd = rsqrtf(wave_sum(ss) * (1.f / DM) + EPS);
        const float* gate = p.MOD + b * 3072 + 2048;
#pragma unroll
        for (int j = 0; j < 2; ++j)
#pragma unroll
            for (int i = 0; i < 2; ++i) { const int c = 8 * lane + 512 * j + 4 * i;
                const f32x4 xv = *(const f32x4*)(xrow + c), gt = *(const f32x4*)(gate + c), gp = *(const f32x4*)(p.g_post + c);
                *(f32x4*)(yrow + c) = xv + gt * (ov[2 * j + i] * rstd * gp); }
    }
}
#define XB_TMO      128
#define XB_XCNT(j)  (256  + 64 * (j))
#define XB_XSUB(j)  (1280 + 64 * (j))
#define XB_XGEN(j)  (2304 + 64 * (j))
#define XB_TOP      3328
#define XB_TOPGEN   3392
#define XCD_BAR_WORDS 3456
#define XB_SPIN_CAP (1u << 18)

__device__ __forceinline__ unsigned xb_ld(unsigned* p)              { return __hip_atomic_load(p, __ATOMIC_RELAXED, __HIP_MEMORY_SCOPE_AGENT); }
__device__ __forceinline__ unsigned xb_add(unsigned* p, unsigned v) { return __hip_atomic_fetch_add(p, v, __ATOMIC_RELAXED, __HIP_MEMORY_SCOPE_AGENT); }
__device__ __forceinline__ unsigned xb_xcc_id() { return (unsigned)__builtin_amdgcn_s_getreg((3 << 11) | 20) & 0xFu; }
#define XB_SPIN(cond, bar) do { unsigned _sp = 0; while (cond) { __builtin_amdgcn_s_sleep(1); \
    if ((++_sp & 255u) == 0u) { if (xb_ld(&(bar)[XB_TMO])) break; if (_sp > XB_SPIN_CAP) { atomicAdd(&(bar)[XB_TMO], 1u); break; } } } } while (0)

struct XcdBarrier {
    unsigned* bar; unsigned x;
    volatile LAS unsigned* st;
};

__device__ __forceinline__ XcdBarrier xcd_barrier_post(unsigned* bar, volatile LAS unsigned* st) {
    XcdBarrier b; b.bar = bar; b.x = xb_xcc_id(); b.st = st;
    if (threadIdx.x == 0) (void)xb_add(&bar[XB_XCNT(b.x)], 1u);
    return b;
}
__device__ __forceinline__ void xcd_barrier_complete(unsigned* bar, unsigned x, unsigned& nloc, unsigned& nx) {
    const unsigned G = gridDim.x * gridDim.y * gridDim.z;
    unsigned sum, cnt, mine, sp = 0u;
    for (;;) {
        sum = 0u; cnt = 0u; mine = 0u;
#pragma unroll
        for (unsigned j = 0; j < 16; ++j) { const unsigned c = xb_ld(&bar[XB_XCNT(j)]); sum += c; cnt += (c > 0u) ? 1u : 0u; mine = (j == x) ? c : mine; }
        if (sum == G) break;
        __builtin_amdgcn_s_sleep(1);
        if ((++sp & 255u) == 0u) { if (xb_ld(&bar[XB_TMO])) break; if (sp > XB_SPIN_CAP) { atomicAdd(&bar[XB_TMO], 1u); break; } }
    }
    nloc = mine > 0u ? mine : 1u; nx = cnt > 0u ? cnt : 1u;
}

__device__ __forceinline__ void xcd_barrier(const XcdBarrier& b) {
    asm volatile("s_waitcnt vmcnt(0)" ::: "memory");
    __syncthreads();
    if (threadIdx.x == 0) {
        unsigned* bar = b.bar;
        __builtin_amdgcn_s_waitcnt(0);
        unsigned nloc = b.st[0], nx = b.st[1];
        if (nloc == 0u) { xcd_barrier_complete(bar, b.x, nloc, nx); b.st[0] = nloc; b.st[1] = nx; }
        const unsigned old = xb_add(&bar[XB_XSUB(b.x)], 1u);
        const unsigned gen = old / nloc;
        if (old + 1u == (gen + 1u) * nloc) {
            __builtin_amdgcn_fence(__ATOMIC_RELEASE, "agent");
            asm volatile("s_waitcnt vmcnt(0)" ::: "memory");
            const unsigned og = xb_add(&bar[XB_TOP], 1u);
            const unsigned tg = og / nx;
            if (og + 1u == (tg + 1u) * nx) xb_add(&bar[XB_TOPGEN], 1u);
            else XB_SPIN(xb_ld(&bar[XB_TOPGEN]) == tg, bar);
            __builtin_amdgcn_fence(__ATOMIC_ACQUIRE, "agent");
            xb_add(&bar[XB_XGEN(b.x)], 1u);
            asm volatile("s_waitcnt vmcnt(0)" ::: "memory");
        } else {
            XB_SPIN(xb_ld(&bar[XB_XGEN(b.x)]) == gen, bar);
            __builtin_amdgcn_fence(__ATOMIC_ACQUIRE, "agent");
            asm volatile("s_waitcnt vmcnt(0)" ::: "memory");
        }
    }
    __syncthreads();
}

#ifndef AT_REP
#define AT_REP 1
#endif
#ifndef GM_REP
#define GM_REP 1
#endif
__global__ void __launch_bounds__(512, 2) hymba_fwd(P p) {
    extern __shared__ __attribute__((aligned(16))) unsigned char lds_raw[];
    cg::grid_group grid = cg::this_grid();
    LAS unsigned char* lds = (LAS unsigned char*)lds_raw;
    int tid = threadIdx.x, lane = tid & 63, wave = __builtin_amdgcn_readfirstlane(tid >> 6);
#define FRESH() do { int t_ = threadIdx.x; asm volatile("" : "+v"(t_)); tid = t_; lane = t_ & 63; wave = __builtin_amdgcn_readfirstlane(t_ >> 6); } while (0)
    const int lo = p.ph_lo, hi = p.ph_hi;
    volatile LAS unsigned* bst = (volatile LAS unsigned*)(lds + LDS_BYTES - 64);
    if (threadIdx.x < 2) bst[threadIdx.x] = 0u;
    __syncthreads();
    XcdBarrier bar; bar.bar = p.BAR; bar.x = 0; bar.st = bst;
    if (hi - lo > 1) bar = xcd_barrier_post(p.BAR, bst);
    if (hi > 1000) grid.sync();
    unsigned long long tp_sum = 0; (void)tp_sum;
#ifdef TPROBE
    unsigned long long tq = wall_clock64();
#define TQ(k) do { const unsigned long long n_ = wall_clock64(); if (TPROBE == (k)) tp_sum += n_ - tq; tq = n_; } while (0)
#else
#define TQ(k) do {} while (0)
#endif
#define IN(k) (lo <= (k) && (k) < hi)
#define SEAM(k) do { if (IN(k) && IN((k) + 1)) xcd_barrier(bar); } while (0)
#ifndef NO_P0
    if (IN(0)) phase0(p, lds, tid, wave, lane);
#endif
    SEAM(0); TQ(20); FRESH();
#ifndef NO_P1
    if (IN(1)) { phase1(p, wave, lane); phase0b(p, lds, tid, wave, lane); }
#endif
    SEAM(1); TQ(21); FRESH();
#ifndef NO_P2
    if (IN(2)) {
        pg8::Gemm g{p.XN, p.WIN, MP, DIN, DM}; pg8::StaticOrder S; S.init(MP, DIN, (int)gridDim.x, (int)blockIdx.x);
        EpiIn E{p.ZB, p.GVT, p.VT, p.STATS, p.out + OUT_KP, p.out + OUT_VP};
        pg8::gemm_phase<EpiIn, pg8::StaticOrder, true, true>(lds, g, S, E);
        for (int un = blockIdx.x; un < DIN / 16; un += gridDim.x) {
            const int n0 = un * 16; const f32x4 a = small_gemm(p.XN + (size_t)MP * DM, p.WIN, n0, wave, lane);
            const int row = wave * 16 + (lane & 15), cp = n0 + 4 * (lane >> 4);
            const int c = cp < 1024 ? ((cp & 255) < 128 ? 128 * (cp >> 8) + (cp & 255) : 1024 + 128 * (cp >> 8) + (cp & 255) - 128) : (cp < 1536 ? cp - 512 : cp), seg = c >> 9; float v[4] = {a[0], a[1], a[2], a[3]};
            if (seg <= 1) {
#pragma unroll
                for (int i = 0; i < 4; ++i) v[i] = gelu_t(v[i]); }
            else if (seg == 2 || seg == 6) {
#pragma unroll
                for (int i = 0; i < 4; ++i) v[i] = silu_f(v[i]); }
            else if (seg == 3) {
#pragma unroll
                for (int i = 0; i < 4; ++i) v[i] *= 0.125f; }
            const f32x4 vv = {v[0], v[1], v[2], v[3]};
            *(f32x4*)(p.ZS + (size_t)row * DIN + c) = vv;
            if (seg == 4) *(f32x4*)(p.out + OUT_KS + (size_t)row * 512 + (c - SEG_K)) = vv;
            if (seg == 5) *(f32x4*)(p.out + OUT_VS + (size_t)row * 512 + (c - SEG_VV)) = vv;
        }
    }

#endif
    TQ(30); SEAM(2); TQ(22); FRESH();
    if (IN(3)) {
        LAS float* biasL = (LAS float*)lds;
        for (int i = tid; i < 8 * 257; i += 512) biasL[i] = p.rel_bias[i];
        __syncthreads();
        LAS unsigned char* wl = lds + 16384 + wave * 9216; LAS float* wscr = (LAS float*)wl;
        const int G_ = (int)gridDim.x, vcu = (G_ % 8 == 0) ? ((int)blockIdx.x % 8) * (G_ / 8) + (int)blockIdx.x / 8 : (int)blockIdx.x;
        const int gw = vcu * 8 + wave, NGW = G_ * 8;
        TQ(9);
        if (blockIdx.x < MS) sattn_block(p, (int)blockIdx.x & 7, (int)blockIdx.x >> 3, (LAS float*)(lds + 16384), biasL, wave, lane);
        TQ(11); FRESH();
        { const int xq = G_ % 8 == 0 ? (int)blockIdx.x % 8 : 0, nq = G_ % 8 == 0 ? 8 : 1;
          unsigned* ctr = p.QCTR + 64 * xq;
          const int n_sg = 64 / nq, n_at = 4096 / nq, n_gm = 2048 / nq, n_all = n_sg + n_at + n_gm;
          int nxt = 0; if (lane == 0) nxt = (int)atomicAdd(ctr, 1u); nxt = __builtin_amdgcn_readfirstlane(nxt);
          while (nxt < n_all) {
              const int it = nxt; FRESH();
              if (it < n_sg) { const int un = it * nq + xq; sgmlp_unit(p, un >> 3, un & 7, lane); }
              else if (it < n_sg + n_at) { const int j = it - n_sg, pair = (j >> 8) * nq + xq, ci = j & 255; attn_unit(p, pair >> 3, pair & 7, ci, biasL + (pair & 7) * 257, wl, lane, tp_sum); }
              else { const int un = (it - n_sg - n_at) * nq + xq, n = un & 127, g = (un >> 7) & 7, b = un >> 10; gmlp_unit(p, b, n, g, wscr, lane); }
              { int v = 0; if (lane == 0) v = (int)atomicAdd(ctr, 1u); nxt = __builtin_amdgcn_readfirstlane(v); }
          }
        }
        TQ(13);
    }

    TQ(31); SEAM(3); TQ(23); FRESH();
#ifndef NO_P4
    if (IN(4)) {
        pg8::Gemm g{p.XN, p.WOUT, MP, DM, DM}; pg8::StaticOrder S; S.init(MP, DM, (int)gridDim.x, (int)blockIdx.x);
        EpiOut E{p.x_prompt, p.out + OUT_YP, p.MOD, p.g_post, p.STATS, p.PCNT};
        pg8::gemm_phase<EpiOut, pg8::StaticOrder, true, true>(lds, g, S, E);
        for (int un = blockIdx.x; un < DM / 16; un += gridDim.x) {
            const int n0 = un * 16; const f32x4 a = small_gemm(p.XN + (size_t)MP * DM, p.WOUT, n0, wave, lane);
            *(f32x4*)(p.OS + (size_t)(wave * 16 + (lane & 15)) * DM + n0 + 4 * (lane >> 4)) = a;
        }
    }

#endif
    TQ(32); SEAM(4); TQ(24); FRESH();
#ifndef NO_P5
    if (IN(5)) phase5(p, wave, lane);
#endif
    TQ(25);
#ifdef TPROBE
    if (blockIdx.x == 8 && wave == 0) { const unsigned long long t0 = wall_clock64(); while (wall_clock64() - t0 < 4ull * tp_sum) __builtin_amdgcn_s_sleep(8); }
#endif
#undef IN
#undef SEAM
}

#ifndef N_LAUNCHES
#define N_LAUNCHES 1
#endif
extern "C" void kernel_launch(void* const* d_in, const int* in_sizes, int n_in, void* d_out, int out_size, void* d_ws, size_t ws_size, hipStream_t stream) {
    static int grid = 0;
    if (grid == 0) {
        if (n_in != 17 || ws_size < WS_END) { fprintf(stderr, "kernel_launch: unexpected n_in %d / ws %zu\n", n_in, ws_size); grid = -1; return; }
        int dev = 0, cus = 0, per_cu = 0;
        if (hipGetDevice(&dev) != hipSuccess || hipDeviceGetAttribute(&cus, hipDeviceAttributeMultiprocessorCount, dev) != hipSuccess) { grid = -1; return; }
        if (hipFuncSetAttribute((const void*)hymba_fwd, hipFuncAttributeMaxDynamicSharedMemorySize, LDS_BYTES) != hipSuccess) { fprintf(stderr, "kernel_launch: hipFuncSetAttribute failed\n"); grid = -1; return; }
        if (hipOccupancyMaxActiveBlocksPerMultiprocessor(&per_cu, (const void*)hymba_fwd, 512, LDS_BYTES) != hipSuccess || per_cu < 1) { fprintf(stderr, "kernel_launch: occupancy query says %d\n", per_cu); grid = -1; return; }
        grid = cus;
    }
    if (grid < 0) return;
    P p{};
    const float** in = (const float**)&p.x_prompt;
    for (int i = 0; i < 17; ++i) in[i] = (const float*)d_in[i];
    unsigned char* ws = (unsigned char*)d_ws;
    p.out = (float*)d_out;
    p.MOD = (float*)(ws + WS_MOD); p.WIN = (bf16_t*)(ws + WS_WIN); p.WOUT = (bf16_t*)(ws + WS_WOUT); p.WST = (bf16_t*)(ws + WS_WST); p.STATS = (float*)(ws + WS_STATS);
    p.XN = (bf16_t*)(ws + WS_XN); p.ZB = (bf16_t*)(ws + WS_ZB); p.GVT = (bf16_t*)(ws + WS_GVT); p.VT = (bf16_t*)(ws + WS_VT); p.OB = (bf16_t*)(ws + WS_OB);
    p.ZS = (float*)(ws + WS_ZS); p.OS = (float*)(ws + WS_OS); p.QCTR = (unsigned*)(ws + WS_QCTR); p.PCNT = (unsigned*)(ws + WS_PCNT); p.BAR = (unsigned*)(ws + WS_BAR);
    if (hipMemsetAsync(ws + WS_BAR, 0, 16384, stream) != hipSuccess) { fprintf(stderr, "kernel_launch: memset failed\n"); return; }
#if N_LAUNCHES == 1
    p.ph_lo = 0; p.ph_hi = 6;
    void* args[] = {&p};
    hipError_t e = hipLaunchCooperativeKernel((const void*)hymba_fwd, dim3(grid), dim3(512), args, LDS_BYTES, stream);
    if (e != hipSuccess) fprintf(stderr, "kernel_launch: cooperative launch failed: %s (grid %d)\n", hipGetErrorString(e), grid);
#else
#ifndef PROBE_REP
#define PROBE_REP -1
#endif
    for (int ph = 0; ph < 6; ++ph) { p.ph_lo = ph; p.ph_hi = ph + 1;
        for (int rep = 0; rep < (ph == PROBE_REP ? 2 : 1); ++rep) hipLaunchKernelGGL(hymba_fwd, dim3(grid), dim3(512), LDS_BYTES, stream, p); }
#endif
}
```
